# Optimizing an MI355X kernel written in HIP

```python
import math
import jax, jax.numpy as jnp
from jax import lax
import numpy as np

D_MODEL = 1024
BATCH = 2
SEQ = 8192
DEPTH = 2

EPS = 1e-6
N_BRANCH = 3
BRANCH_W = 1024
W_A = BRANCH_W
LRU_BLOCKS = 4
LRU_BLOCK = W_A // LRU_BLOCKS
CONV_W = 4
LRU_C = 8.0
W_B = BRANCH_W
RWKV_HEAD = 64
RWKV_HEADS = W_B // RWKV_HEAD
DECAY_LORA = 64
ICLR_LORA = 64
RWKV_GN_EPS = 64e-5
W_C = BRANCH_W
RET_HEADS = 4
RET_HEAD = W_C // RET_HEADS
RET_CHUNK = 128
ROPE_BASE = 10000.0
RET_GN_EPS = 1e-5
B_COLS = 4 * W_B + DECAY_LORA + ICLR_LORA
C_COLS = 4 * W_C
OFF_GA = W_A
OFF_B = 2 * W_A
OFF_C = OFF_B + B_COLS
OFF_M = OFF_C + C_COLS
N_IN = OFF_M + N_BRANCH * D_MODEL

kernel_name = "hybrid_rglru_rwkv7_retention_gated_merge"


def rms_norm(x, w):
    xf = x.astype(jnp.float32)
    y = xf * lax.rsqrt(jnp.mean(xf * xf, axis=-1, keepdims=True) + EPS)
    return (y * w).astype(x.dtype)


def head_norm(y, eps):
    mu = jnp.mean(y, axis=-1, keepdims=True)
    var = jnp.mean(jnp.square(y - mu), axis=-1, keepdims=True)
    return (y - mu) * lax.rsqrt(var + eps)


def rglru_branch(xa, conv_w, conv_b, gate_w, gate_b, lam):
    bsz, s, _ = xa.shape
    xf = xa.astype(jnp.float32)
    xp = jnp.pad(xf, ((0, 0), (CONV_W - 1, 0), (0, 0)))
    conv = conv_b + sum(xp[:, j:j + s] * conv_w[j] for j in range(CONV_W))
    xb = conv.reshape(bsz, s, LRU_BLOCKS, LRU_BLOCK)
    g = jnp.einsum("bsnc,gncd->gbsnd", xb, gate_w).reshape(2, bsz, s, W_A) + gate_b[:, None, None, :]
    r = jax.nn.sigmoid(g[0])
    i = jax.nn.sigmoid(g[1])
    log_a = -LRU_C * r * jax.nn.softplus(-lam)
    a = jnp.exp(log_a)
    mult = jnp.sqrt(jnp.maximum(-jnp.expm1(2.0 * log_a), 0.0))
    mult = jnp.where((jnp.arange(s) == 0)[None, :, None], 1.0, mult)
    b = mult * i * conv

    def combine(left, right):
        a1, b1 = left
        a2, b2 = right
        return a1 * a2, a2 * b1 + b2

    _, h = lax.associative_scan(combine, (a, b), axis=1)
    return h


def rwkv7_branch(pb, mu, w0, w2, a0, a2, k_k, k_a, r_k, lnx_w, lnx_b):
    bsz, s, _ = pb.shape
    pf = pb.astype(jnp.float32)
    prev = jnp.pad(pf, ((0, 0), (1, 0), (0, 0)))[:, :s]
    pf = pf + (prev - pf) * mu
    r, k, v, g, wl, al = jnp.split(pf, [W_B, 2 * W_B, 3 * W_B, 4 * W_B, 4 * W_B + DECAY_LORA], axis=-1)
    w_log = -jax.nn.softplus(-(w0 + jnp.tanh(wl) @ w2)) - 0.5
    decay = jnp.exp(-jnp.exp(w_log))
    a = jax.nn.sigmoid(a0 + al @ a2)
    hd = lambda t: t.reshape(bsz, s, RWKV_HEADS, RWKV_HEAD)
    kk = hd(k * k_k)
    kk = kk / jnp.maximum(jnp.linalg.norm(kk, axis=-1, keepdims=True), 1e-12)
    k = k * (1.0 + (a - 1.0) * k_a)
    rh, kh, vh, wh, ah = hd(r), hd(k), hd(v), hd(decay), hd(a)

    def step(state, inp):
        r_t, w_t, k_t, v_t, kk_t, a_t = inp
        sa = jnp.einsum("bhvk,bhk->bhv", state, -kk_t)
        state = (state * w_t[:, :, None, :]
                 + sa[..., None] * (kk_t * a_t)[:, :, None, :]
                 + v_t[..., None] * k_t[:, :, None, :])
        y = jnp.einsum("bhvk,bhk->bhv", state, r_t)
        return state, y

    tm = lambda t: jnp.moveaxis(t, 1, 0)
    s0 = jnp.zeros((bsz, RWKV_HEADS, RWKV_HEAD, RWKV_HEAD), jnp.float32)
    _, y = lax.scan(step, s0, (tm(rh), tm(wh), tm(kh), tm(vh), tm(kk), tm(ah)))
    y = jnp.moveaxis(y, 0, 1)
    y = head_norm(y, RWKV_GN_EPS).reshape(bsz, s, W_B) * lnx_w + lnx_b
    bonus = (jnp.sum(rh * kh * r_k, axis=-1, keepdims=True) * vh).reshape(bsz, s, W_B)
    return (y + bonus) * jax.nn.silu(g)


def rotary(t, pos):
    half = t.shape[-1] // 2
    inv_freq = 1.0 / (ROPE_BASE ** jnp.linspace(0.0, 1.0, half, dtype=jnp.float32))
    ang = pos[:, None].astype(jnp.float32) * inv_freq
    cos = jnp.cos(ang)[None, :, None, :]
    sin = jnp.sin(ang)[None, :, None, :]
    t1, t2 = t[..., :half], t[..., half:]
    return jnp.concatenate([t1 * cos - t2 * sin, t1 * sin + t2 * cos], axis=-1)


def retention_branch(pc):
    bsz, s, _ = pc.shape
    nc = s // RET_CHUNK
    q, k, v, g = jnp.split(pc.astype(jnp.float32), 4, axis=-1)
    pos = jnp.arange(s)
    hd = lambda t: t.reshape(bsz, s, RET_HEADS, RET_HEAD)
    q = rotary(hd(q), pos)
    k = rotary(hd(k), pos) * (RET_HEAD ** -0.5)
    v = hd(v)
    log_g = jnp.log1p(-jnp.exp2(-5.0 - jnp.arange(RET_HEADS, dtype=jnp.float32)))
    idx = jnp.arange(RET_CHUNK)
    rel = idx[:, None] - idx[None, :]
    mask = jnp.where(rel >= 0, jnp.exp(log_g[:, None, None] * jnp.maximum(rel, 0)), 0.0)
    ch = lambda t: t.reshape(bsz, nc, RET_CHUNK, RET_HEADS, RET_HEAD)
    qc, kc, vc = ch(q), ch(k), ch(v)
    scores = jnp.einsum("bnihd,bnjhd->bnhij", qc, kc) * mask
    inner = jnp.einsum("bnhij,bnjhd->bnihd", scores, vc)
    q_decay = jnp.exp(log_g[None, :] * (idx[:, None] + 1.0))[None, :, :, None]
    k_decay = jnp.exp(log_g[None, :] * (RET_CHUNK - 1.0 - idx[:, None]))[None, :, :, None]
    chunk_decay = jnp.exp(log_g * RET_CHUNK)[None, :, None, None]

    def step(state, inp):
        qn, kn, vn = inp
        cross = jnp.einsum("bihd,bhde->bihe", qn * q_decay, state)
        state = state * chunk_decay + jnp.einsum("bjhd,bjhe->bhde", kn * k_decay, vn)
        return state, cross

    r0 = jnp.zeros((bsz, RET_HEADS, RET_HEAD, RET_HEAD), jnp.float32)
    tm = lambda t: jnp.moveaxis(t, 1, 0)
    _, cross = lax.scan(step, r0, (tm(qc), tm(kc), tm(vc)))
    out = (inner + jnp.moveaxis(cross, 0, 1)).reshape(bsz, s, RET_HEADS, RET_HEAD)
    out = head_norm(out, RET_GN_EPS).reshape(bsz, s, W_C)
    return out * jax.nn.silu(g)


def hybrid_layer(x, norm_w, w_in, b_merge, conv_w, conv_b, lru_gate_w, lru_gate_b, lru_lambda,
                 shift_mu, decay_w0, decay_w2, iclr_a0, iclr_a2, k_k, k_a, r_k, lnx_w, lnx_b,
                 w_branch, w_out):
    bsz, s, _ = x.shape
    h = rms_norm(x, norm_w)
    p = h @ w_in
    xa, ga, pb, pc, pm = jnp.split(p, [OFF_GA, OFF_B, OFF_C, OFF_M], axis=-1)
    y_a = rglru_branch(xa, conv_w, conv_b, lru_gate_w, lru_gate_b, lru_lambda) * jax.nn.silu(ga.astype(jnp.float32))
    y_b = rwkv7_branch(pb, shift_mu, decay_w0, decay_w2, iclr_a0, iclr_a2, k_k, k_a, r_k, lnx_w, lnx_b)
    y_c = retention_branch(pc)
    ys = jnp.stack([y_a, y_b, y_c], axis=0).astype(x.dtype)
    proj = jnp.einsum("nbsw,nwd->bsnd", ys, w_branch)
    gates = jax.nn.sigmoid((pm + b_merge).reshape(bsz, s, N_BRANCH, D_MODEL).astype(jnp.float32))
    merged = jnp.sum(gates * proj, axis=2).astype(x.dtype)
    return x + merged @ w_out


def setup_inputs(seed: int = 0) -> dict:
    key = jax.random.key(seed)
    ks = jax.random.split(key, 22)
    f32 = jnp.float32
    nrm = lambda k, shp: jax.random.normal(k, shp, f32)
    a_c = jax.random.uniform(ks[8], (DEPTH, W_A), f32, 0.9, 0.999)
    a_base = a_c ** (1.0 / LRU_C)
    return {
        "x": nrm(ks[0], (BATCH, SEQ, D_MODEL)),
        "norm_w": 1.0 + 0.02 * nrm(ks[1], (DEPTH, D_MODEL)),
        "w_in": nrm(ks[2], (DEPTH, D_MODEL, N_IN)) * D_MODEL ** -0.5,
        "b_merge": 0.02 * nrm(ks[3], (DEPTH, N_BRANCH * D_MODEL)),
        "conv_w": nrm(ks[4], (DEPTH, CONV_W, W_A)) * CONV_W ** -0.5,
        "conv_b": 0.02 * nrm(ks[5], (DEPTH, W_A)),
        "lru_gate_w": nrm(ks[6], (DEPTH, 2, LRU_BLOCKS, LRU_BLOCK, LRU_BLOCK)) * LRU_BLOCK ** -0.5,
        "lru_gate_b": 0.02 * nrm(ks[7], (DEPTH, 2, W_A)),
        "lru_lambda": jnp.log(a_base) - jnp.log1p(-a_base),
        "shift_mu": jax.random.uniform(ks[9], (DEPTH, B_COLS), f32),
        "decay_w0": jax.random.uniform(ks[10], (DEPTH, W_B), f32, -6.0, -1.0),
        "decay_w2": nrm(ks[11], (DEPTH, DECAY_LORA, W_B)) * 0.5 * DECAY_LORA ** -0.5,
        "iclr_a0": 0.1 * nrm(ks[12], (DEPTH, W_B)),
        "iclr_a2": nrm(ks[13], (DEPTH, ICLR_LORA, W_B)) * ICLR_LORA ** -0.5,
        "k_k": 0.85 + 0.05 * nrm(ks[14], (DEPTH, W_B)),
        "k_a": 1.0 + 0.05 * nrm(ks[15], (DEPTH, W_B)),
        "r_k": 0.1 * nrm(ks[16], (DEPTH, RWKV_HEADS, RWKV_HEAD)),
        "lnx_w": 1.0 + 0.02 * nrm(ks[17], (DEPTH, W_B)),
        "lnx_b": 0.02 * nrm(ks[18], (DEPTH, W_B)),
        "w_branch": nrm(ks[19], (DEPTH, N_BRANCH, BRANCH_W, D_MODEL)) * BRANCH_W ** -0.5,
        "w_out": nrm(ks[20], (DEPTH, D_MODEL, D_MODEL)) * D_MODEL ** -0.5,
        "final_norm_w": 1.0 + 0.02 * nrm(ks[21], (D_MODEL,)),
    }


def reference(x, norm_w, w_in, b_merge, conv_w, conv_b, lru_gate_w, lru_gate_b, lru_lambda,
              shift_mu, decay_w0, decay_w2, iclr_a0, iclr_a2, k_k, k_a, r_k, lnx_w, lnx_b,
              w_branch, w_out, final_norm_w):
    for l in range(DEPTH):
        x = hybrid_layer(x, norm_w[l], w_in[l], b_merge[l], conv_w[l], conv_b[l], lru_gate_w[l],
                         lru_gate_b[l], lru_lambda[l], shift_mu[l], decay_w0[l], decay_w2[l],
                         iclr_a0[l], iclr_a2[l], k_k[l], k_a[l], r_k[l], lnx_w[l], lnx_b[l],
                         w_branch[l], w_out[l])
    return rms_norm(x, final_norm_w)
```

```cpp
#include <hip/hip_runtime.h>
#include <hip/hip_cooperative_groups.h>
#include <cstdio>
namespace cg = cooperative_groups;

#ifndef MULTI_LAUNCH
#define MULTI_LAUNCH 1
#endif

typedef unsigned short bf16_t;
#define T_TOK 16384
#define SEQ 8192
#define DM 1024
#define NIN 13440
#define UNIT 33554432ull

struct Params {
    const float* x; const float* norm_w; const float* w_in; const float* b_merge; const float* conv_w; const float* conv_b;
    const float* gate_w; const float* gate_b; const float* lam; const float* mu; const float* w0; const float* w2;
    const float* a0; const float* a2; const float* k_k; const float* k_a; const float* r_k; const float* lnx_w; const float* lnx_b;
    const float* w_branch; const float* w_out; const float* fnorm_w;
    float* out; unsigned char* ws; unsigned long long ws_size;
};

__device__ __forceinline__ float bf2f(bf16_t b) { return __uint_as_float(((unsigned)b) << 16); }
__device__ __forceinline__ bf16_t f2bf(float f) { unsigned u = __float_as_uint(f); u += 0x7FFFu + ((u >> 16) & 1u); return (bf16_t)(u >> 16); }
__device__ __forceinline__ float toF(float v) { return v; }
__device__ __forceinline__ float toF(bf16_t v) { return bf2f(v); }
__device__ __forceinline__ float sigmoidf_(float v) { return 1.0f / (1.0f + expf(-v)); }
__device__ __forceinline__ float siluf_(float v) { return v / (1.0f + expf(-v)); }
__device__ __forceinline__ float softplusf_(float v) { return v > 20.f ? v : log1pf(expf(v)); }

__device__ __forceinline__ bf16_t* REG(const Params& p, int r) { return (bf16_t*)(p.ws + (size_t)r * UNIT); }
#define R_H 0
#define R_CQ 1
#define R_XA 1
#define R_LD 1
#define R_CK 2
#define R_GA 2
#define R_CV 3
#define R_BR 3
#define R_CG 4
#define R_SN 5
#define R_BK 5
#define R_BV 6
#define R_MG 6
#define R_SC 7
#define R_BG 7
#define R_CVB 8
#define R_AA 8
#define R_PM 8
#define R_LA 9
#define R_LB 10
#define R_MISC 11
#define OFF_BL 0ull
#define OFF_ROPE (8ull << 20)

__device__ __forceinline__ float wave_sum(float v) {
#pragma unroll
    for (int o = 32; o > 0; o >>= 1) v += __shfl_xor(v, o);
    return v;
}
__device__ __forceinline__ float block_sum256(float v, float* red) {
    v = wave_sum(v);
    const int w = threadIdx.x >> 6;
    __syncthreads();
    if ((threadIdx.x & 63) == 0) red[w] = v;
    __syncthreads();
    return red[0] + red[1] + red[2] + red[3];
}

template <typename AT, class Epi>
__device__ void gemm_naive(const AT* __restrict__ A, int lda, const float* __restrict__ B, int ldb, int M, int N, int K, const Epi& epi, int vb, int nvb, float* smem) {
    float (*sA)[68] = (float (*)[68])smem;
    float (*sB)[64] = (float (*)[64])(smem + 16 * 68);
    const int tid = threadIdx.x, ty = tid >> 4, tx = tid & 15;
    const int ntn = N / 64, ntiles = (M / 64) * ntn;
    for (int tile = vb; tile < ntiles; tile += nvb) {
        const int tm = (tile / ntn) * 64, tn = (tile % ntn) * 64;
        float acc[4][4];
#pragma unroll
        for (int i = 0; i < 4; ++i)
#pragma unroll
            for (int j = 0; j < 4; ++j) acc[i][j] = 0.f;
        for (int k0 = 0; k0 < K; k0 += 16) {
            {
                const int r = tid >> 2, kk = (tid & 3) * 4;
                const AT* ap = A + (size_t)(tm + r) * lda + k0 + kk;
#pragma unroll
                for (int j = 0; j < 4; ++j) sA[kk + j][r] = toF(ap[j]);
            }
            {
                const int kr = tid >> 4, c = (tid & 15) * 4;
                const float4 v = *(const float4*)(B + (size_t)(k0 + kr) * ldb + tn + c);
                sB[kr][c] = v.x; sB[kr][c + 1] = v.y; sB[kr][c + 2] = v.z; sB[kr][c + 3] = v.w;
            }
            __syncthreads();
#pragma unroll
            for (int kk = 0; kk < 16; ++kk) {
                float a[4], b[4];
#pragma unroll
                for (int i = 0; i < 4; ++i) { a[i] = sA[kk][ty * 4 + i]; b[i] = sB[kk][tx * 4 + i]; }
#pragma unroll
                for (int i = 0; i < 4; ++i)
#pragma unroll
                    for (int j = 0; j < 4; ++j) acc[i][j] += a[i] * b[j];
            }
            __syncthreads();
        }
#pragma unroll
        for (int i = 0; i < 4; ++i)
#pragma unroll
            for (int j = 0; j < 4; ++j) epi(tm + ty * 4 + i, tn + tx * 4 + j, acc[i][j]);
    }
}

struct EpiSplit {
    unsigned char* ws; int thr;
    __device__ __forceinline__ void operator()(int r, int c, float v) const { const int g = c >> 10; const int rg = 1 + g + (g >= thr ? 1 : 0);
        ((bf16_t*)(ws + (size_t)rg * UNIT))[(size_t)r * DM + (c & 1023)] = f2bf(v); }
};
struct EpiBL { bf16_t* dst; __device__ __forceinline__ void operator()(int r, int c, float v) const { dst[(size_t)r * 128 + c] = f2bf(v); } };
struct EpiPM { bf16_t* dst; const float* bias; __device__ __forceinline__ void operator()(int r, int c, float v) const { dst[(size_t)(c >> 10) * (UNIT / 2) + (size_t)r * DM + (c & 1023)] = f2bf(sigmoidf_(v + bias[c])); } };
struct EpiOut { const float* xin; float* xout; __device__ __forceinline__ void operator()(int r, int c, float v) const { const size_t i = (size_t)r * DM + c; xout[i] = xin[i] + v; } };

__device__ void ph_rms(const Params& p, const float* xin, const float* w, bf16_t* H, int vb, int nvb, float* smem) {
    for (int row = vb; row < T_TOK; row += nvb) {
        const float4 v = *(const float4*)(xin + (size_t)row * DM + threadIdx.x * 4);
        const float ss = block_sum256(v.x * v.x + v.y * v.y + v.z * v.z + v.w * v.w, smem);
        const float rs = rsqrtf(ss * (1.0f / DM) + 1e-6f);
        const float4 wv = *(const float4*)(w + threadIdx.x * 4);
        bf16_t* hp = H + (size_t)row * DM + threadIdx.x * 4;
        hp[0] = f2bf(v.x * rs * wv.x); hp[1] = f2bf(v.y * rs * wv.y); hp[2] = f2bf(v.z * rs * wv.z); hp[3] = f2bf(v.w * rs * wv.w);
    }
}
__device__ void ph_final(const Params& p, int vb, int nvb, float* smem) {
    for (int row = vb; row < T_TOK; row += nvb) {
        float* xp = p.out + (size_t)row * DM + threadIdx.x * 4;
        const float4 v = *(const float4*)xp;
        const float ss = block_sum256(v.x * v.x + v.y * v.y + v.z * v.z + v.w * v.w, smem);
        const float rs = rsqrtf(ss * (1.0f / DM) + 1e-6f);
        const float4 wv = *(const float4*)(p.fnorm_w + threadIdx.x * 4);
        float4 o; o.x = v.x * rs * wv.x; o.y = v.y * rs * wv.y; o.z = v.z * rs * wv.z; o.w = v.w * rs * wv.w;
        *(float4*)xp = o;
    }
}
__device__ void ph_rope_table(const Params& p, int vb, int nvb) {
    float2* tab = (float2*)(p.ws + (size_t)R_MISC * UNIT + OFF_ROPE);
    for (int i = vb * 256 + threadIdx.x; i < SEQ * 128; i += nvb * 256) {
        const int pos = i >> 7, d = i & 127;
        const float lin = (float)d / 127.0f;
        const float invf = 1.0f / (float)pow(10000.0, (double)lin);
        const float ang = (float)pos * invf;
        double s, c; sincos((double)ang, &s, &c);
        tab[i] = make_float2((float)c, (float)s);
    }
}
__device__ void ph_rotary(const Params& p, int vb, int nvb) {
    const float2* tab = (const float2*)(p.ws + (size_t)R_MISC * UNIT + OFF_ROPE);
    bf16_t* Q = REG(p, R_CQ); bf16_t* Kb = REG(p, R_CK);
    const size_t n = (size_t)T_TOK * 4 * 128;
    for (size_t i = (size_t)vb * 256 + threadIdx.x; i < n; i += (size_t)nvb * 256) {
        const int d = (int)(i & 127), h = (int)((i >> 7) & 3); const int t = (int)(i >> 9);
        const float2 cs = tab[(size_t)(t & (SEQ - 1)) * 128 + d];
        const size_t o = (size_t)t * DM + h * 256 + d;
        { const float t1 = bf2f(Q[o]), t2 = bf2f(Q[o + 128]); Q[o] = f2bf(t1 * cs.x - t2 * cs.y); Q[o + 128] = f2bf(t1 * cs.y + t2 * cs.x); }
        { const float t1 = bf2f(Kb[o]), t2 = bf2f(Kb[o + 128]); Kb[o] = f2bf((t1 * cs.x - t2 * cs.y) * 0.0625f); Kb[o + 128] = f2bf((t1 * cs.y + t2 * cs.x) * 0.0625f); }
    }
}
__device__ __forceinline__ float ret_logg(int h) { return (float)log1p(-exp2(-5.0 - (double)h)); }
__device__ void ph_ret_scores(const Params& p, int vb, int nvb) {
    const bf16_t* Q = REG(p, R_CQ); const bf16_t* Kb = REG(p, R_CK); float* SC = (float*)REG(p, R_SC);
    const size_t n = (size_t)512 * 128 * 128;
    for (size_t idx = (size_t)vb * 256 + threadIdx.x; idx < n; idx += (size_t)nvb * 256) {
        const int j = (int)(idx & 127), i = (int)((idx >> 7) & 127); const int u = (int)(idx >> 14);
        const int h = u & 3, bn = u >> 2;
        float v = 0.f;
        if (j <= i) {
            const bf16_t* qp = Q + (size_t)(bn * 128 + i) * DM + h * 256; const bf16_t* kp = Kb + (size_t)(bn * 128 + j) * DM + h * 256;
            float s = 0.f;
            for (int d = 0; d < 256; ++d) s += bf2f(qp[d]) * bf2f(kp[d]);
            v = s * expf(ret_logg(h) * (float)(i - j));
        }
        SC[idx] = v;
    }
}
__device__ void ph_ret_states(const Params& p, int vb, int nvb) {
    const bf16_t* Kb = REG(p, R_CK); const bf16_t* V = REG(p, R_CV); bf16_t* SN = REG(p, R_SN);
    const int n = 8 * 256 * 256;
    for (int idx = vb * 256 + threadIdx.x; idx < n; idx += nvb * 256) {
        const int e = idx & 255, d = (idx >> 8) & 255, bh = idx >> 16; const int h = bh & 3, b = bh >> 2;
        const float lg = ret_logg(h); const float cd = expf(lg * 128.0f);
        float st = 0.f;
        for (int c = 0; c < 64; ++c) {
            SN[((size_t)((b * 64 + c) * 4 + h) * 256 + d) * 256 + e] = f2bf(st);
            float acc = 0.f;
            const size_t t0 = (size_t)b * SEQ + c * 128;
            for (int j = 0; j < 128; ++j) acc += bf2f(Kb[(t0 + j) * DM + h * 256 + d]) * expf(lg * (float)(127 - j)) * bf2f(V[(t0 + j) * DM + h * 256 + e]);
            st = st * cd + acc;
        }
    }
}
__device__ void ph_ret_out(const Params& p, int vb, int nvb, float* smem) {
    const bf16_t* Q = REG(p, R_CQ); const bf16_t* V = REG(p, R_CV); const bf16_t* SN = REG(p, R_SN); const float* SC = (const float*)REG(p, R_SC);
    bf16_t* G = REG(p, R_CG);
    const int e = threadIdx.x;
    for (int u = vb; u < T_TOK * 4; u += nvb) {
        const int h = u & 3, t = u >> 2; const int i = t & 127, bn = t >> 7;
        const float* sc = SC + ((size_t)(bn * 4 + h) * 128 + i) * 128;
        float o = 0.f;
        for (int j = 0; j <= i; ++j) o += sc[j] * bf2f(V[(size_t)(bn * 128 + j) * DM + h * 256 + e]);
        const float qd = expf(ret_logg(h) * (float)(i + 1));
        const bf16_t* qp = Q + (size_t)t * DM + h * 256; const bf16_t* sn = SN + (size_t)(bn * 4 + h) * 65536 + e;
        float cr = 0.f;
        for (int d = 0; d < 256; ++d) cr += bf2f(qp[d]) * bf2f(sn[(size_t)d * 256]);
        o += cr * qd;
        const float mean = block_sum256(o, smem) * (1.0f / 256.0f);
        const float dv = o - mean;
        const float var = block_sum256(dv * dv, smem) * (1.0f / 256.0f);
        const float y = dv * rsqrtf(var + 1e-5f);
        const size_t gi = (size_t)t * DM + h * 256 + e;
        G[gi] = f2bf(y * siluf_(bf2f(G[gi])));
    }
}
__device__ void ph_conv(const Params& p, int l, int vb, int nvb) {
    const bf16_t* XA = REG(p, R_XA); bf16_t* CVb = REG(p, R_CVB);
    const float* cw = p.conv_w + (size_t)l * 4 * DM; const float* cb = p.conv_b + (size_t)l * DM;
    const size_t n = (size_t)T_TOK * DM;
    for (size_t idx = (size_t)vb * 256 + threadIdx.x; idx < n; idx += (size_t)nvb * 256) {
        const int ch = (int)(idx & 1023); const int t = (int)(idx >> 10); const int s = t & (SEQ - 1);
        float acc = cb[ch];
#pragma unroll
        for (int j = 0; j < 4; ++j) { const int ss = s - 3 + j; if (ss >= 0) acc += cw[j * DM + ch] * bf2f(XA[(size_t)(t - 3 + j) * DM + ch]); }
        CVb[idx] = f2bf(acc);
    }
}
__device__ void ph_lru_gates(const Params& p, int l, int vb, int nvb) {
    const bf16_t* CVb = REG(p, R_CVB); bf16_t* LA = REG(p, R_LA); bf16_t* LB = REG(p, R_LB);
    const float* gw = p.gate_w + (size_t)l * 2 * 4 * 256 * 256; const float* gb = p.gate_b + (size_t)l * 2 * DM; const float* lam = p.lam + (size_t)l * DM;
    const size_t n = (size_t)T_TOK * DM;
    for (size_t idx = (size_t)vb * 256 + threadIdx.x; idx < n; idx += (size_t)nvb * 256) {
        const int ch = (int)(idx & 1023); const int t = (int)(idx >> 10); const int nb = ch >> 8, d = ch & 255;
        const bf16_t* cp = CVb + (size_t)t * DM + nb * 256;
        const float* w0p = gw + ((size_t)(0 * 4 + nb) * 256) * 256 + d; const float* w1p = gw + ((size_t)(1 * 4 + nb) * 256) * 256 + d;
        float g0 = gb[ch], g1 = gb[DM + ch];
        for (int c = 0; c < 256; ++c) { const float cv = bf2f(cp[c]); g0 += cv * w0p[(size_t)c * 256]; g1 += cv * w1p[(size_t)c * 256]; }
        const float r = sigmoidf_(g0), ig = sigmoidf_(g1);
        const float log_a = -8.0f * r * softplusf_(-lam[ch]);
        float mult = sqrtf(fmaxf(-expm1f(2.0f * log_a), 0.f));
        if ((t & (SEQ - 1)) == 0) mult = 1.0f;
        LA[idx] = f2bf(log_a);
        LB[idx] = f2bf(mult * ig * bf2f(cp[d]));
    }
}
__device__ void ph_lru_scan(const Params& p, int vb, int nvb) {
    const bf16_t* LA = REG(p, R_LA); const bf16_t* LB = REG(p, R_LB); bf16_t* GA = REG(p, R_GA);
    for (int idx = vb * 256 + threadIdx.x; idx < 2 * DM; idx += nvb * 256) {
        const int ch = idx & 1023, b = idx >> 10;
        float h = 0.f;
        for (int s = 0; s < SEQ; ++s) {
            const size_t i = ((size_t)b * SEQ + s) * DM + ch;
            h = expf(bf2f(LA[i])) * h + bf2f(LB[i]);
            GA[i] = f2bf(h * siluf_(bf2f(GA[i])));
        }
    }
}
__device__ void ph_rwkv_prep(const Params& p, int l, int vb, int nvb) {
    const bf16_t* BL = (const bf16_t*)(p.ws + (size_t)R_MISC * UNIT + OFF_BL); bf16_t* LD = REG(p, R_LD); bf16_t* AA = REG(p, R_AA);
    const float* mu = p.mu + (size_t)l * 4224 + 4096; const float* w2 = p.w2 + (size_t)l * 64 * DM; const float* a2 = p.a2 + (size_t)l * 64 * DM;
    const float* w0 = p.w0 + (size_t)l * DM; const float* a0 = p.a0 + (size_t)l * DM;
    const size_t n = (size_t)T_TOK * DM;
    for (size_t idx = (size_t)vb * 256 + threadIdx.x; idx < n; idx += (size_t)nvb * 256) {
        const int ch = (int)(idx & 1023); const int t = (int)(idx >> 10); const bool first = (t & (SEQ - 1)) == 0;
        const bf16_t* cur = BL + (size_t)t * 128; const bf16_t* prv = cur - 128;
        float dw = 0.f, da = 0.f;
        for (int j = 0; j < 64; ++j) {
            const float c0 = bf2f(cur[j]), p0 = first ? 0.f : bf2f(prv[j]);
            const float c1 = bf2f(cur[64 + j]), p1 = first ? 0.f : bf2f(prv[64 + j]);
            const float wl = c0 + (p0 - c0) * mu[j], al = c1 + (p1 - c1) * mu[64 + j];
            dw += tanhf(wl) * w2[(size_t)j * DM + ch]; da += al * a2[(size_t)j * DM + ch];
        }
        const float w_log = -softplusf_(-(w0[ch] + dw)) - 0.5f;
        LD[idx] = f2bf(-expf(w_log));
        AA[idx] = f2bf(sigmoidf_(a0[ch] + da));
    }
}
__device__ void ph_rwkv_rec(const Params& p, int l, int vb, int nvb, float* smem) {
    const int wave = threadIdx.x >> 6, lane = threadIdx.x & 63;
    float* sh = smem + wave * 5 * 64;
    const bf16_t* BR = REG(p, R_BR); const bf16_t* BK = REG(p, R_BK); const bf16_t* BV = REG(p, R_BV); bf16_t* BG = REG(p, R_BG);
    const bf16_t* LD = REG(p, R_LD); const bf16_t* AA = REG(p, R_AA);
    for (int ub = vb; ub < 8; ub += nvb) {
        const int unit = ub * 4 + wave; const int h = unit & 15, b = unit >> 4; const int ch = h * 64 + lane;
        const float* mu = p.mu + (size_t)l * 4224;
        const float mu_r = mu[ch], mu_k = mu[DM + ch], mu_v = mu[2 * DM + ch], mu_g = mu[3 * DM + ch];
        const float kk_w = p.k_k[(size_t)l * DM + ch], ka_w = p.k_a[(size_t)l * DM + ch], rk_w = p.r_k[(size_t)l * DM + ch];
        const float ln_w = p.lnx_w[(size_t)l * DM + ch], ln_b = p.lnx_b[(size_t)l * DM + ch];
        float st[64];
#pragma unroll
        for (int k = 0; k < 64; ++k) st[k] = 0.f;
        float pr = 0.f, pk = 0.f, pv = 0.f, pg = 0.f;
        for (int s = 0; s < SEQ; ++s) {
            const size_t i = ((size_t)b * SEQ + s) * DM + ch;
            const float cr = bf2f(BR[i]), ck = bf2f(BK[i]), cv = bf2f(BV[i]), cgv = bf2f(BG[i]);
            const float r = cr + (pr - cr) * mu_r, k = ck + (pk - ck) * mu_k, v = cv + (pv - cv) * mu_v, g = cgv + (pg - cgv) * mu_g;
            pr = cr; pk = ck; pv = cv; pg = cgv;
            const float w = expf(bf2f(LD[i])), a = bf2f(AA[i]);
            const float kkc = k * kk_w;
            const float nrm = sqrtf(wave_sum(kkc * kkc));
            const float kk = kkc / fmaxf(nrm, 1e-12f);
            const float kh = k * (1.0f + (a - 1.0f) * ka_w);
            const float bonus_s = wave_sum(r * kh * rk_w);
            __syncthreads();
            sh[lane] = r; sh[64 + lane] = w; sh[128 + lane] = kh; sh[192 + lane] = kk; sh[256 + lane] = kk * a;
            __syncthreads();
            float sa = 0.f;
#pragma unroll
            for (int kx = 0; kx < 64; ++kx) sa -= st[kx] * sh[192 + kx];
            float y = 0.f;
#pragma unroll
            for (int kx = 0; kx < 64; ++kx) { st[kx] = st[kx] * sh[64 + kx] + sa * sh[256 + kx] + v * sh[128 + kx]; y += st[kx] * sh[kx]; }
            const float mean = wave_sum(y) * (1.0f / 64.0f);
            const float dv = y - mean;
            const float var = wave_sum(dv * dv) * (1.0f / 64.0f);
            const float yn = dv * rsqrtf(var + 64e-5f) * ln_w + ln_b;
            BG[i] = f2bf((yn + bonus_s * v) * siluf_(g));
        }
    }
}
__device__ void ph_merge(const Params& p, int l, int vb, int nvb, float* smem) {
    float (*sA)[68] = (float (*)[68])smem;
    float (*sB)[64] = (float (*)[64])(smem + 16 * 68);
    const int tid = threadIdx.x, ty = tid >> 4, tx = tid & 15;
    const bf16_t* PM = REG(p, R_PM); bf16_t* MG = REG(p, R_MG);
    const int ntn = DM / 64, ntiles = (T_TOK / 64) * ntn;
    for (int tile = vb; tile < ntiles; tile += nvb) {
        const int tm = (tile / ntn) * 64, tn = (tile % ntn) * 64;
        float tot[4][4];
#pragma unroll
        for (int i = 0; i < 4; ++i)
#pragma unroll
            for (int j = 0; j < 4; ++j) tot[i][j] = 0.f;
        for (int nb = 0; nb < 3; ++nb) {
            const bf16_t* A = nb == 0 ? REG(p, R_GA) : (nb == 1 ? REG(p, R_BG) : REG(p, R_CG)); const float* B = p.w_branch + ((size_t)l * 3 + nb) * DM * DM;
            float acc[4][4];
#pragma unroll
            for (int i = 0; i < 4; ++i)
#pragma unroll
                for (int j = 0; j < 4; ++j) acc[i][j] = 0.f;
            for (int k0 = 0; k0 < DM; k0 += 16) {
                { const int r = tid >> 2, kk = (tid & 3) * 4; const bf16_t* ap = A + (size_t)(tm + r) * DM + k0 + kk;
#pragma unroll
                  for (int j = 0; j < 4; ++j) sA[kk + j][r] = bf2f(ap[j]); }
                { const int kr = tid >> 4, c = (tid & 15) * 4; const float4 v = *(const float4*)(B + (size_t)(k0 + kr) * DM + tn + c);
                  sB[kr][c] = v.x; sB[kr][c + 1] = v.y; sB[kr][c + 2] = v.z; sB[kr][c + 3] = v.w; }
                __syncthreads();
#pragma unroll
                for (int kk = 0; kk < 16; ++kk) {
                    float a[4], bb[4];
#pragma unroll
                    for (int i = 0; i < 4; ++i) { a[i] = sA[kk][ty * 4 + i]; bb[i] = sB[kk][tx * 4 + i]; }
#pragma unroll
                    for (int i = 0; i < 4; ++i)
#pragma unroll
                        for (int j = 0; j < 4; ++j) acc[i][j] += a[i] * bb[j];
                }
                __syncthreads();
            }
#pragma unroll
            for (int i = 0; i < 4; ++i)
#pragma unroll
                for (int j = 0; j < 4; ++j) tot[i][j] += bf2f(PM[(size_t)nb * (UNIT / 2) + (size_t)(tm + ty * 4 + i) * DM + tn + tx * 4 + j]) * acc[i][j];
        }
#pragma unroll
        for (int i = 0; i < 4; ++i)
#pragma unroll
            for (int j = 0; j < 4; ++j) MG[(size_t)(tm + ty * 4 + i) * DM + tn + tx * 4 + j] = f2bf(tot[i][j]);
    }
}

#define N_PH 16
__device__ void run_phase(const Params& p, int l, int ph, int vb, int nvb, float* smem) {
    const float* xin = l == 0 ? p.x : p.out;
    const float* win = p.w_in + (size_t)l * DM * NIN;
    switch (ph) {
    case 0: ph_rms(p, xin, p.norm_w + (size_t)l * DM, REG(p, R_H), vb, nvb, smem); ph_rope_table(p, vb, nvb); break;
    case 1: { EpiSplit e; e.ws = p.ws; e.thr = 99;
              gemm_naive<bf16_t>(REG(p, R_H), DM, win + 6272, NIN, T_TOK, 4096, DM, e, vb, nvb, smem); } break;
    case 2: ph_rotary(p, vb, nvb); break;
    case 3: ph_ret_scores(p, vb, nvb); break;
    case 4: ph_ret_states(p, vb, nvb); break;
    case 5: ph_ret_out(p, vb, nvb, smem); break;
    case 6: { EpiSplit e; e.ws = p.ws; e.thr = 3;
              gemm_naive<bf16_t>(REG(p, R_H), DM, win, NIN, T_TOK, 6144, DM, e, vb, nvb, smem);
              EpiBL eb; eb.dst = (bf16_t*)(p.ws + (size_t)R_MISC * UNIT + OFF_BL);
              gemm_naive<bf16_t>(REG(p, R_H), DM, win + 6144, NIN, T_TOK, 128, DM, eb, vb, nvb, smem); } break;
    case 7: ph_conv(p, l, vb, nvb); break;
    case 8: ph_lru_gates(p, l, vb, nvb); break;
    case 9: ph_lru_scan(p, vb, nvb); break;
    case 10: ph_rwkv_prep(p, l, vb, nvb); break;
    case 11: ph_rwkv_rec(p, l, vb, nvb, smem); break;
    case 12: break;
    case 13: { EpiPM e; e.dst = REG(p, R_PM); e.bias = p.b_merge + (size_t)l * 3072;
               gemm_naive<bf16_t>(REG(p, R_H), DM, win + 10368, NIN, T_TOK, 3072, DM, e, vb, nvb, smem); } break;
    case 14: ph_merge(p, l, vb, nvb, smem); break;
    case 15: { EpiOut e; e.xin = xin; e.xout = p.out;
               gemm_naive<bf16_t>(REG(p, R_MG), DM, p.w_out + (size_t)l * DM * DM, DM, T_TOK, DM, DM, e, vb, nvb, smem); } break;
    default: break;
    }
}

__global__ void __launch_bounds__(256) k_phase(Params p, int l, int ph) {
    __shared__ float smem[16 * 68 + 16 * 64];
    if (ph == 100) ph_final(p, blockIdx.x, gridDim.x, smem);
    else run_phase(p, l, ph, blockIdx.x, gridDim.x, smem);
}

__global__ void __launch_bounds__(256) k_mega(Params p) {
    __shared__ float smem[16 * 68 + 16 * 64];
    cg::grid_group grid = cg::this_grid();
    for (int l = 0; l < 2; ++l)
        for (int ph = 0; ph < N_PH; ++ph) { run_phase(p, l, ph, blockIdx.x, gridDim.x, smem); grid.sync(); }
    ph_final(p, blockIdx.x, gridDim.x, smem);
}

extern "C" void kernel_launch(void* const* d_in, const int* in_sizes, int n_in,
                              void* d_out, int out_size, void* d_ws, size_t ws_size,
                              hipStream_t stream) {
    Params p{};
    const float** f = (const float**)&p;
    for (int i = 0; i < 22; ++i) f[i] = (const float*)d_in[i];
    p.out = (float*)d_out; p.ws = (unsigned char*)d_ws; p.ws_size = (unsigned long long)ws_size;
    if (ws_size < 12ull * UNIT + (32ull << 20)) { fprintf(stderr, "workspace too small\n"); return; }
#if MULTI_LAUNCH
    for (int l = 0; l < 2; ++l)
        for (int ph = 0; ph < N_PH; ++ph) {
            if (ph == 12) continue;
            hipLaunchKernelGGL(k_phase, dim3(2048), dim3(256), 0, stream, p, l, ph);
        }
    hipLaunchKernelGGL(k_phase, dim3(2048), dim3(256), 0, stream, p, 0, 100);
#else
    static int grid_blocks = 0;
    if (!grid_blocks) {
        int dev = 0, cus = 0, per_cu = 0;
        (void)hipGetDevice(&dev);
        (void)hipDeviceGetAttribute(&cus, hipDeviceAttributeMultiprocessorCount, dev);
        (void)hipOccupancyMaxActiveBlocksPerMultiprocessor(&per_cu, k_mega, 256, 0);
        if (per_cu > 4) per_cu = 4;
        grid_blocks = cus * per_cu;
    }
    void* args[] = {&p};
    hipError_t e = hipLaunchCooperativeKernel((void*)k_mega, dim3(grid_blocks), dim3(256), args, 0, stream);
    if (e != hipSuccess) fprintf(stderr, "cooperative launch failed: %s (grid %d)\n", hipGetErrorString(e), grid_blocks);
#endif
}
```

```cpp
#include <hip/hip_runtime.h>
#include <hip/hip_cooperative_groups.h>
#include <cstdio>
namespace cg = cooperative_groups;

#ifndef MULTI_LAUNCH
#define MULTI_LAUNCH 0
#ifdef WITH_DEBUG_CHECK
#define DEBUG_CHECK 1
#endif
#endif

typedef unsigned short bf16_t;
#define LAS __attribute__((address_space(3)))
#define T_TOK 16384
#define SEQ 8192
#define DM 1024
#define NIN 13440
#define NT 512
#define UNIT 33554432ull
#define LDS_STAGE 131072
#define RW_LDS_MISC (19 * 8192)
#define RW_LDS_PRM (RW_LDS_MISC + 4096)
#define LDS_BYTES (RW_LDS_MISC + 4096 + 3072)

#define PARAM_FIELDS(X) X(const float*, x) X(const float*, norm_w) X(const float*, w_in) X(const float*, b_merge) X(const float*, conv_w) X(const float*, conv_b) \
    X(const float*, gate_w) X(const float*, gate_b) X(const float*, lam) X(const float*, mu) X(const float*, w0) X(const float*, w2) \
    X(const float*, a0) X(const float*, a2) X(const float*, k_k) X(const float*, k_a) X(const float*, r_k) X(const float*, lnx_w) X(const float*, lnx_b) \
    X(const float*, w_branch) X(const float*, w_out) X(const float*, fnorm_w) X(float*, out) X(unsigned char*, ws)
struct Params {
#define X(T, n) T n;
    PARAM_FIELDS(X)
#undef X
    unsigned long long ws_size;
    int ph_lo, ph_hi, run, pad;
};
template <class T> __device__ __forceinline__ T* uni_ptr(T* p) { const unsigned long long v = (unsigned long long)p;
    const unsigned lo = __builtin_amdgcn_readfirstlane((unsigned)v), hi = __builtin_amdgcn_readfirstlane((unsigned)(v >> 32)); return (T*)(((unsigned long long)hi << 32) | lo); }
__device__ __forceinline__ Params load_params(const __attribute__((address_space(3))) Params* lp) {
    Params q;
#define X(T, n) q.n = uni_ptr(lp->n);
    PARAM_FIELDS(X)
#undef X
    q.ws_size = 0; q.ph_lo = 0; q.ph_hi = 0; return q;
}

__device__ __forceinline__ float bf2f(bf16_t b) { return __uint_as_float(((unsigned)b) << 16); }
__device__ __forceinline__ bf16_t f2bf(float f) { unsigned u = __float_as_uint(f); u += 0x7FFFu + ((u >> 16) & 1u); return (bf16_t)(u >> 16); }
__device__ __forceinline__ unsigned pk2(float lo, float hi) { return (unsigned)f2bf(lo) | ((unsigned)f2bf(hi) << 16); }
__device__ __forceinline__ float sigmoidf_(float v) { return 1.0f / (1.0f + expf(-v)); }
__device__ __forceinline__ float siluf_(float v) { return v / (1.0f + expf(-v)); }
__device__ __forceinline__ float softplusf_(float v) { return v > 20.f ? v : log1pf(expf(v)); }
__device__ __forceinline__ float fexp_(float v) { return __builtin_amdgcn_exp2f(v * 1.4426950408889634f); }
__device__ __forceinline__ float fsigmoid_(float v) { return __builtin_amdgcn_rcpf(1.0f + fexp_(-v)); }
__device__ __forceinline__ float fsilu_(float v) { return v * fsigmoid_(v); }
__device__ __forceinline__ float one_minus_exp_(float x) { const float pl = -x * (1.0f + x * (0.5f + x * (0.16666667f + x * 0.041666668f))), ex = 1.0f - fexp_(x); return x > -0.02f ? pl : ex; }
#define LAUNDER_V(x) asm volatile("" : "+v"(x))

__device__ __forceinline__ bf16_t* REG(const Params& p, int r) { return (bf16_t*)(p.ws + (size_t)r * UNIT); }
#define R_H 0
#define R_CQ 1
#define R_XA 1
#define R_LD 1
#define R_CK 2
#define R_GA 2
#define R_CV 3
#define R_BR 3
#define R_CG 4
#define R_SN 5
#define R_BK 5
#define R_BV 6
#define R_MG 6
#define R_SC 7
#define R_BG 7
#define R_CVB 8
#define R_AA 8
#define R_PM 8
#define R_LA 9
#define R_LB 10
#define R_MISC 11
#define OFF_BL 0ull
#define OFF_ROPE (4ull << 20)
#define OFF_WIN (12ull << 20)
#define OFF_WBR (OFF_WIN + 13440ull * 1024 * 2)
#define OFF_WOUT (OFF_WBR + 3ull * 1024 * 1024 * 2)
#define OFF_WG (OFF_WOUT + 1024ull * 1024 * 2)
#define OFF_BAR (OFF_WG + 2048ull * 256 * 2)
#define OFF_PROG (OFF_BAR + 16384ull)
#define OFF_AGG (OFF_BAR + 65536ull)
#define OFF_W2T (OFF_AGG + 3ull * 2 * 256 * 1024 * 4)
#define OFF_A2T (OFF_W2T + 1024ull * 64 * 2)
#define OFF_GC (OFF_A2T + 1024ull * 64 * 2)
#define OFF_BON (OFF_GC + 4096ull * 64 * 4)
#define OFF_SSQ (OFF_BON + 16384ull * 16 * 4)
#define OFF_END (OFF_SSQ + 2ull * 4 * 16384 * 4)
#define MISC(p, off) ((p).ws + (size_t)R_MISC * UNIT + (off))

__device__ __forceinline__ float wave_sum(float v) {
#pragma unroll
    for (int o = 32; o > 0; o >>= 1) v += __shfl_xor(v, o);
    return v;
}
__device__ __forceinline__ float half_sum(float v, LAS float* red) {
    v = wave_sum(v);
    const int w = threadIdx.x >> 6;
    __syncthreads();
    if ((threadIdx.x & 63) == 0) red[w] = v;
    __syncthreads();
    const int hb = (threadIdx.x >> 8) * 4;
    return (red[hb] + red[hb + 1]) + (red[hb + 2] + red[hb + 3]);
}


#define XB_TMO      128
#define XB_XCNT(j)  (256  + 64 * (j))
#define XB_XSUB(j)  (1280 + 64 * (j))
#define XB_XGEN(j)  (2304 + 64 * (j))
#define XB_TOP      3328
#define XB_TOPGEN   3392
#define XCD_BAR_WORDS 3456
#define XB_SPIN_CAP (1u << 22)
__device__ __forceinline__ unsigned xb_ld(unsigned* p)              { return __hip_atomic_load(p, __ATOMIC_RELAXED, __HIP_MEMORY_SCOPE_AGENT); }
__device__ __forceinline__ unsigned xb_add(unsigned* p, unsigned v) { return __hip_atomic_fetch_add(p, v, __ATOMIC_RELAXED, __HIP_MEMORY_SCOPE_AGENT); }
__device__ __forceinline__ unsigned xb_xcc_id() { return (unsigned)__builtin_amdgcn_s_getreg((3 << 11) | 20) & 0xFu; }
#define XB_SPIN(cond, bar) do { unsigned _sp = 0; while (cond) { __builtin_amdgcn_s_sleep(1); \
    if ((++_sp & 255u) == 0u) { if (xb_ld(&(bar)[XB_TMO])) break; if (_sp > XB_SPIN_CAP) { atomicAdd(&(bar)[XB_TMO], 1u); break; } } } } while (0)
struct XcdBarrier { unsigned* bar; unsigned x; volatile LAS unsigned* st; };
__device__ __forceinline__ XcdBarrier xcd_barrier_post(unsigned* bar, volatile LAS unsigned* st) {
    XcdBarrier b; b.bar = bar; b.x = xb_xcc_id(); b.st = st;
    if (threadIdx.x == 0) (void)xb_add(&bar[XB_XCNT(b.x)], 1u);
    return b;
}
__device__ __forceinline__ void xcd_barrier_complete(unsigned* bar, unsigned x, unsigned& nloc, unsigned& nx) {
    const unsigned G = gridDim.x * gridDim.y * gridDim.z;
    unsigned sum, cnt, mine, sp = 0u;
    for (;;) {
        sum = 0u; cnt = 0u; mine = 0u;
#pragma unroll
        for (unsigned j = 0; j < 16; ++j) { const unsigned c = xb_ld(&bar[XB_XCNT(j)]); sum += c; cnt += (c > 0u) ? 1u : 0u; mine = (j == x) ? c : mine; }
        if (sum == G) break;
        __builtin_amdgcn_s_sleep(1);
        if ((++sp & 255u) == 0u) { if (xb_ld(&bar[XB_TMO])) break; if (sp > XB_SPIN_CAP) { atomicAdd(&bar[XB_TMO], 1u); break; } }
    }
    nloc = mine > 0u ? mine : 1u; nx = cnt > 0u ? cnt : 1u;
}
__device__ __forceinline__ void xcd_barrier(const XcdBarrier& b) {
    asm volatile("s_waitcnt vmcnt(0)" ::: "memory");
    __syncthreads();
    if (threadIdx.x == 0) {
        unsigned* bar = b.bar;
        __builtin_amdgcn_s_waitcnt(0);
        unsigned nloc = b.st[0], nx = b.st[1];
        if (nloc == 0u) { xcd_barrier_complete(bar, b.x, nloc, nx); b.st[0] = nloc; b.st[1] = nx; }
        const unsigned old = xb_add(&bar[XB_XSUB(b.x)], 1u);
        const unsigned gen = old / nloc;
        if (old + 1u == (gen + 1u) * nloc) {
            __builtin_amdgcn_fence(__ATOMIC_RELEASE, "agent");
            asm volatile("s_waitcnt vmcnt(0)" ::: "memory");
            const unsigned og = xb_add(&bar[XB_TOP], 1u);
            const unsigned tg = og / nx;
            if (og + 1u == (tg + 1u) * nx) xb_add(&bar[XB_TOPGEN], 1u);
            else XB_SPIN(xb_ld(&bar[XB_TOPGEN]) == tg, bar);
            __builtin_amdgcn_fence(__ATOMIC_ACQUIRE, "agent");
            xb_add(&bar[XB_XGEN(b.x)], 1u);
            asm volatile("s_waitcnt vmcnt(0)" ::: "memory");
        } else {
            XB_SPIN(xb_ld(&bar[XB_XGEN(b.x)]) == gen, bar);
            __builtin_amdgcn_fence(__ATOMIC_ACQUIRE, "agent");
            asm volatile("s_waitcnt vmcnt(0)" ::: "memory");
        }
    }
    __syncthreads();
}

namespace pg8 {
typedef short bf16x8 __attribute__((ext_vector_type(8)));
typedef float f32x4 __attribute__((ext_vector_type(4)));
typedef unsigned u32x4 __attribute__((ext_vector_type(4)));
typedef unsigned u32x2 __attribute__((ext_vector_type(2)));
constexpr int BM = 256, BK = 64, HALF = 128, HTB = HALF * BK * 2, STAGE_BYTES = 8 * HTB, NXCD = 8, WGM = 8;

__host__ __device__ __forceinline__ int lds_byte(int r, int c) { const int st = (r >> 4) * 2 + (c >> 5), rr = r & 15, cc = c & 31, ob = rr * 64 + cc * 2; return st * 1024 + (ob ^ (((ob >> 9) & 1) << 5)); }
__host__ __device__ __forceinline__ void stage_rc(int b, int& R, int& C) { const int st = b / 1024, sb = b % 1024, swz = sb ^ (((sb >> 9) & 1) << 5); R = (st >> 1) * 16 + swz / 64; C = (st & 1) * 32 + (swz % 64) / 2; }
__host__ __device__ __forceinline__ int perm32(int rho) { const int n = rho >> 4, i = rho & 15; return 8 * (i >> 2) + 4 * n + (i & 3); }
typedef __bf16 bf16x2_t __attribute__((ext_vector_type(2)));
typedef float f32x2_t __attribute__((ext_vector_type(2)));
__device__ __forceinline__ unsigned cvt_pk_bf16(float lo, float hi) { const f32x2_t v = {lo, hi}; const bf16x2_t b = __builtin_convertvector(v, bf16x2_t); return __builtin_bit_cast(unsigned, b); }

struct Unit { int pm, pn, z; };

struct StaticOrder {
    int nM, nN, nwg, G, c;
    __device__ __forceinline__ void init(int M, int N, int G_, int c_) { nM = M / BM; nN = N / BM; nwg = nM * nN; G = G_; c = c_; }
    __device__ __forceinline__ bool next(int i, Unit& u) const {
        const long L = (long)i * G + c; if (L >= nwg) return false;
        int wgid = (int)L; { const int q = nwg / NXCD, r = nwg % NXCD, xcd = wgid % NXCD, off = wgid / NXCD; wgid = (xcd < r ? xcd * (q + 1) : r * (q + 1) + (xcd - r) * q) + off; }
        const int nig = WGM * nN, gid = wgid / nig, fm = gid * WGM, gsz = (nM - fm) < WGM ? (nM - fm) : WGM;
        u.pm = fm + ((wgid % nig) % gsz); u.pn = (wgid % nig) / gsz; u.z = 0; return true;
    }
};
template <int NZ> struct StaticOrderZ {
    StaticOrder s;
    __device__ __forceinline__ bool next(int i, Unit& u) const { const int q = i / NZ; if (!s.next(q, u)) return false; u.z = i - q * NZ; return true; }
};

template <class G, class Epi, class Sched, bool ALIGN_EPI, bool SP2>
__device__ __forceinline__ void gemm_phase(LAS unsigned char* lds, const G& g, const Sched& S, const Epi& E) {
    int tid = threadIdx.x; LAUNDER_V(tid);
    const int wid = __builtin_amdgcn_readfirstlane(tid >> 6), lane = tid & 63, wr = wid >> 2, wc = wid & 3, fr = lane & 15, fq = lane >> 4;
    const int nt = g.K / BK;
    unsigned voffA[2], voffB[2];
#pragma unroll
    for (int i = 0; i < 2; ++i) { int R, C; stage_rc(tid * 16 + i * 8192, R, C); const int Rb = Epi::PERM ? ((R & ~31) + perm32(R & 31)) : R;
        voffA[i] = (unsigned)(R * g.lda + C) * 2u; voffB[i] = (unsigned)(Rb * g.ldb + C) * 2u; }
    const size_t hstepA = (size_t)HALF * g.lda * 2, hstepB = (size_t)HALF * g.ldb * 2;
    const unsigned ldsw = (unsigned)wid * 1024u;
    const int aoff = lds_byte(wr * 64 + fr, fq * 8), boff = lds_byte(wc * 32 + fr, fq * 8);
#define PG8_SA(b, h) (((b) * 2 + (h)) * HTB)
#define PG8_SB(b, h) ((4 + (b) * 2 + (h)) * HTB)
#define PG8_STAGE(bufoff, gbase, voff) do { _Pragma("unroll") for (int _i = 0; _i < 2; ++_i) \
        __builtin_amdgcn_global_load_lds((const unsigned*)((const char*)(gbase) + (voff)[_i]), (LAS unsigned*)(lds + (bufoff) + ldsw + _i * 8192), 16, 0, 0); } while (0)
#define PG8_LDA(dst, b, h) do { _Pragma("unroll") for (int m = 0; m < 4; ++m) _Pragma("unroll") for (int k = 0; k < 2; ++k) dst[m][k] = *(const LAS bf16x8*)(lds + PG8_SA(b, h) + aoff + m * 2048 + k * 1024); } while (0)
#define PG8_LDB(dst, b, h) do { _Pragma("unroll") for (int n = 0; n < 2; ++n) _Pragma("unroll") for (int k = 0; k < 2; ++k) dst[n][k] = *(const LAS bf16x8*)(lds + PG8_SB(b, h) + boff + n * 2048 + k * 1024); } while (0)
#define PG8_MMA(ai, bj, At, Bt) do { __builtin_amdgcn_s_setprio(1); _Pragma("unroll") for (int m = 0; m < 4; ++m) _Pragma("unroll") for (int n = 0; n < 2; ++n) _Pragma("unroll") for (int k = 0; k < 2; ++k) \
        acc[ai][bj][m][n] = __builtin_amdgcn_mfma_f32_16x16x32_bf16(Bt[n][k], At[m][k], acc[ai][bj][m][n], 0, 0, 0); __builtin_amdgcn_s_setprio(0); } while (0)
#ifdef SAFE_GEMM
#define PG8_WAIT_V(n) asm volatile("s_waitcnt vmcnt(0)" ::: "memory")
#else
#define PG8_WAIT_V(n) asm volatile("s_waitcnt vmcnt(" #n ")" ::: "memory")
#endif
#define PG8_WAIT_L(n) asm volatile("s_waitcnt lgkmcnt(" #n ")" ::: "memory")
#define PG8_BAR __builtin_amdgcn_s_barrier()
#define PG8_SCHED __builtin_amdgcn_sched_barrier(0)
    Unit cur, nxt; int ui = 0;
    if (!S.next(0, cur)) return;
    f32x4 acc[2][2][4][2];
#pragma unroll
    for (int a = 0; a < 2; ++a)
#pragma unroll
        for (int b = 0; b < 2; ++b)
#pragma unroll
            for (int m = 0; m < 4; ++m)
#pragma unroll
                for (int n = 0; n < 2; ++n) acc[a][b][m][n] = (f32x4){0.f, 0.f, 0.f, 0.f};
    bf16x8 At[4][2], B0[2][2], B1[2][2];
    {
        const char* cA0 = g.aptr(cur, 0); const char* cB0 = g.bptr(cur, 0); const char* cA1 = g.aptr(cur, 1); const char* cB1 = g.bptr(cur, 1);
        static_assert(SP2, "only the SP2 loop is kept");
        PG8_STAGE(PG8_SB(0, 0), cB0, voffB); PG8_STAGE(PG8_SB(0, 1), cB0 + hstepB, voffB); PG8_STAGE(PG8_SA(0, 0), cA0, voffA); PG8_STAGE(PG8_SA(0, 1), cA0 + hstepA, voffA);
        if (wr == 1) PG8_BAR;
        PG8_WAIT_V(2); PG8_BAR;
        PG8_STAGE(PG8_SB(1, 0), cB1, voffB); PG8_STAGE(PG8_SA(1, 0), cA1, voffA); PG8_STAGE(PG8_SB(1, 1), cB1 + hstepB, voffB);
        PG8_WAIT_V(6); PG8_BAR;
    }
    for (;;) {
        const bool has_next = S.next(ui + 1, nxt);
        const Unit nx = has_next ? nxt : cur;
        for (int t = 0; t < nt; t += 2) {
            const bool last = (t == nt - 2);
            const char* a1 = g.aptr(cur, t + 1);
            const char* a2 = last ? g.aptr(nx, 0) : g.aptr(cur, t + 2); const char* b2 = last ? g.bptr(nx, 0) : g.bptr(cur, t + 2);
            const char* a3 = last ? g.aptr(nx, 1) : g.aptr(cur, t + 3); const char* b3 = last ? g.bptr(nx, 1) : g.bptr(cur, t + 3);
            PG8_LDB(B0, 0, 0); PG8_LDB(B1, 0, 1); PG8_SCHED; PG8_LDA(At, 0, 0); PG8_STAGE(PG8_SA(1, 1), a1 + hstepA, voffA);
            PG8_WAIT_V(8); PG8_WAIT_L(0); PG8_BAR; PG8_MMA(0, 0, At, B0); PG8_MMA(0, 1, At, B1); PG8_BAR; PG8_SCHED;
            PG8_LDA(At, 0, 1); PG8_STAGE(PG8_SB(0, 0), b2, voffB); PG8_STAGE(PG8_SB(0, 1), b2 + hstepB, voffB); PG8_STAGE(PG8_SA(0, 0), a2, voffA);
            PG8_WAIT_V(8); PG8_WAIT_L(0); PG8_BAR; PG8_MMA(1, 0, At, B0); PG8_MMA(1, 1, At, B1); PG8_BAR; PG8_SCHED;
            PG8_LDB(B0, 1, 0); PG8_LDB(B1, 1, 1); PG8_SCHED; PG8_LDA(At, 1, 0); PG8_STAGE(PG8_SA(0, 1), a2 + hstepA, voffA);
            PG8_WAIT_V(8); PG8_WAIT_L(0); PG8_BAR; PG8_MMA(0, 0, At, B0); PG8_MMA(0, 1, At, B1); PG8_BAR; PG8_SCHED;
            PG8_LDA(At, 1, 1); PG8_STAGE(PG8_SB(1, 0), b3, voffB); PG8_STAGE(PG8_SB(1, 1), b3 + hstepB, voffB); PG8_STAGE(PG8_SA(1, 0), a3, voffA);
            PG8_WAIT_V(8); PG8_WAIT_L(0); PG8_BAR; PG8_MMA(1, 0, At, B0); PG8_MMA(1, 1, At, B1); PG8_BAR; PG8_SCHED;
        }
        if constexpr (ALIGN_EPI) { if (wr == 0) PG8_BAR; }
        if constexpr (!Epi::AFTER_DRAIN) E(acc, cur, wr, wc, fr, fq);
        if (!has_next) break;
#pragma unroll
        for (int a = 0; a < 2; ++a)
#pragma unroll
            for (int b = 0; b < 2; ++b)
#pragma unroll
                for (int m = 0; m < 4; ++m)
#pragma unroll
                    for (int n = 0; n < 2; ++n) acc[a][b][m][n] = (f32x4){0.f, 0.f, 0.f, 0.f};
        cur = nxt; ++ui;
        if constexpr (ALIGN_EPI) { if (wr == 1) PG8_BAR; }
    }
    PG8_WAIT_V(0);
    if constexpr (!ALIGN_EPI) { if (wr == 0) PG8_BAR; }
    PG8_BAR;
    if constexpr (Epi::AFTER_DRAIN) E.fused(acc, cur, wr, wc, fr, fq, lds, wid, lane);
#undef PG8_SA
#undef PG8_SB
#undef PG8_STAGE
#undef PG8_LDA
#undef PG8_LDB
#undef PG8_MMA
#undef PG8_WAIT_V
#undef PG8_WAIT_L
#undef PG8_BAR
#undef PG8_SCHED
}
}
using pg8::f32x4; using pg8::u32x4; using pg8::Unit;

struct GPlain {
    const char* A; const char* Bt; int K, lda, ldb;
    __device__ __forceinline__ const char* aptr(const Unit& u, int t) const { return A + ((size_t)u.pm * 256 * lda + (size_t)t * 64) * 2; }
    __device__ __forceinline__ const char* bptr(const Unit& u, int t) const { return Bt + ((size_t)u.pn * 256 * ldb + (size_t)t * 64) * 2; }
};
struct GGate {
    const char* A; const char* Bt; int K, lda, ldb;
    __device__ __forceinline__ const char* aptr(const Unit& u, int t) const { return A + ((size_t)u.pm * 256 * 1024 + (size_t)(u.pn >> 1) * 256 + (size_t)t * 64) * 2; }
    __device__ __forceinline__ const char* bptr(const Unit& u, int t) const { return Bt + ((size_t)u.pn * 256 * 256 + (size_t)t * 64) * 2; }
};
struct GMerge6 {
    const char* H; const char* Wm; const char* Y0; const char* Y1; const char* Y2; const char* Bt; int K, lda, ldb;
    __device__ __forceinline__ const char* aptr(const Unit& u, int t) const { const char* y = u.z < 3 ? H : (u.z == 3 ? Y0 : (u.z == 4 ? Y1 : Y2)); return y + ((size_t)u.pm * 256 * 1024 + (size_t)t * 64) * 2; }
    __device__ __forceinline__ const char* bptr(const Unit& u, int t) const { return u.z < 3 ? Wm + ((size_t)(u.z * 1024 + u.pn * 256) * 1024 + (size_t)t * 64) * 2 : Bt + ((size_t)(u.z - 3) * 1024 * 1024 + (size_t)u.pn * 256 * 1024 + (size_t)t * 64) * 2; }
};
struct GMerge {
    const char* Y0; const char* Y1; const char* Y2; const char* Bt; int K, lda, ldb;
    __device__ __forceinline__ const char* aptr(const Unit& u, int t) const { const char* y = u.z == 0 ? Y0 : (u.z == 1 ? Y1 : Y2); return y + ((size_t)u.pm * 256 * 1024 + (size_t)t * 64) * 2; }
    __device__ __forceinline__ const char* bptr(const Unit& u, int t) const { return Bt + ((size_t)u.z * 1024 * 1024 + (size_t)u.pn * 256 * 1024 + (size_t)t * 64) * 2; }
};

__device__ __forceinline__ u32x4 pack8(const f32x4& v0, const f32x4& v1) {
    u32x4 w; w.x = pg8::cvt_pk_bf16(v0[0], v0[1]); w.y = pg8::cvt_pk_bf16(v0[2], v0[3]); w.z = pg8::cvt_pk_bf16(v1[0], v1[1]); w.w = pg8::cvt_pk_bf16(v1[2], v1[3]); return w;
}
__device__ __forceinline__ void unpack8(const u32x4& w, f32x4& v0, f32x4& v1) {
    v0[0] = __uint_as_float(w.x << 16); v0[1] = __uint_as_float(w.x & 0xffff0000u); v0[2] = __uint_as_float(w.y << 16); v0[3] = __uint_as_float(w.y & 0xffff0000u);
    v1[0] = __uint_as_float(w.z << 16); v1[1] = __uint_as_float(w.z & 0xffff0000u); v1[2] = __uint_as_float(w.w << 16); v1[3] = __uint_as_float(w.w & 0xffff0000u);
}
struct WtBuf { __amdgpu_buffer_rsrc_t r; const char* b; };
__device__ __forceinline__ WtBuf wt_make(const void* base) { WtBuf w; w.r = __builtin_amdgcn_make_buffer_rsrc((void*)base, 0, 0x7fffffff, 0x00020000); w.b = (const char*)base; return w; }
__device__ __forceinline__ void wt_st16(const WtBuf& w, const void* ptr, u32x4 v) { __builtin_amdgcn_raw_buffer_store_b128(v, w.r, (unsigned)((const char*)ptr - w.b), 0, 16); }
__device__ __forceinline__ void wt_st8(const WtBuf& w, const void* ptr, pg8::u32x2 v) { __builtin_amdgcn_raw_buffer_store_b64(v, w.r, (unsigned)((const char*)ptr - w.b), 0, 16); }
__device__ __forceinline__ void wt16(const void* base, const void* ptr, u32x4 v) { wt_st16(wt_make(base), ptr, v); }
__device__ __forceinline__ void wt16f(const void* base, const void* ptr, f32x4 v) { wt_st16(wt_make(base), ptr, __builtin_bit_cast(u32x4, v)); }
__device__ __forceinline__ void wt8(const void* base, const void* ptr, pg8::u32x2 v) { wt_st8(wt_make(base), ptr, v); }
struct EpiC {
    static constexpr bool PERM = true, AFTER_DRAIN = false;
    unsigned char* ws; const float2* tab;
    __device__ __forceinline__ void operator()(const f32x4 (&acc_)[2][2][4][2], const Unit& u, int wr, int wc, int fr, int fq) const {
        f32x4 (&acc)[2][2][4][2] = const_cast<f32x4 (&)[2][2][4][2]>(acc_);
        const int which = u.pn >> 2, head = u.pn & 3;
        bf16_t* base = (bf16_t*)(ws + (size_t)(R_CQ + which) * UNIT);
        const int row0 = u.pm * 256 + wr * 64 + fr, d0 = wc * 32 + 8 * fq;
        if (which < 2) {
            const float sc = which == 1 ? 0.0625f : 1.0f;
#pragma unroll
            for (int ai = 0; ai < 2; ++ai)
#pragma unroll
                for (int m = 0; m < 4; ++m) {
                    const int row = row0 + ai * 128 + m * 16;
                    const f32x4* tp = (const f32x4*)(tab + (size_t)(row & (SEQ - 1)) * 128 + d0);
                    const f32x4 c0 = tp[0], c1 = tp[1], c2 = tp[2], c3 = tp[3];
                    const f32x4 lo0 = acc[ai][0][m][0], lo1 = acc[ai][0][m][1], hi0 = acc[ai][1][m][0], hi1 = acc[ai][1][m][1];
                    f32x4 a0, a1, b0, b1;
                    a0[0] = (lo0[0] * c0[0] - hi0[0] * c0[1]) * sc; b0[0] = (lo0[0] * c0[1] + hi0[0] * c0[0]) * sc;
                    a0[1] = (lo0[1] * c0[2] - hi0[1] * c0[3]) * sc; b0[1] = (lo0[1] * c0[3] + hi0[1] * c0[2]) * sc;
                    a0[2] = (lo0[2] * c1[0] - hi0[2] * c1[1]) * sc; b0[2] = (lo0[2] * c1[1] + hi0[2] * c1[0]) * sc;
                    a0[3] = (lo0[3] * c1[2] - hi0[3] * c1[3]) * sc; b0[3] = (lo0[3] * c1[3] + hi0[3] * c1[2]) * sc;
                    a1[0] = (lo1[0] * c2[0] - hi1[0] * c2[1]) * sc; b1[0] = (lo1[0] * c2[1] + hi1[0] * c2[0]) * sc;
                    a1[1] = (lo1[1] * c2[2] - hi1[1] * c2[3]) * sc; b1[1] = (lo1[1] * c2[3] + hi1[1] * c2[2]) * sc;
                    a1[2] = (lo1[2] * c3[0] - hi1[2] * c3[1]) * sc; b1[2] = (lo1[2] * c3[1] + hi1[2] * c3[0]) * sc;
                    a1[3] = (lo1[3] * c3[2] - hi1[3] * c3[3]) * sc; b1[3] = (lo1[3] * c3[3] + hi1[3] * c3[2]) * sc;
                    acc[ai][0][m][0] = a0; acc[ai][0][m][1] = a1; acc[ai][1][m][0] = b0; acc[ai][1][m][1] = b1;
                }
        }
#pragma unroll
        for (int ai = 0; ai < 2; ++ai)
#pragma unroll
            for (int m = 0; m < 4; ++m) {
                const int row = row0 + ai * 128 + m * 16;
                bf16_t* rowp = base + (size_t)row * DM + head * 256 + d0;
                const f32x4 lo0 = acc[ai][0][m][0], lo1 = acc[ai][0][m][1], hi0 = acc[ai][1][m][0], hi1 = acc[ai][1][m][1];
                if (which != 2) { wt16(ws, rowp, pack8(lo0, lo1)); wt16(ws, rowp + 128, pack8(hi0, hi1)); }
                if (which == 1 || which == 2) {
                    const int j = wr * 64 + fr + ai * 128 + m * 16;
                    const float sc = which == 1 ? exp2f(log2f(1.0f - exp2f(-5.0f - (float)head)) * (float)(255 - j)) : 1.0f;
                    bf16_t* tb = (bf16_t*)(ws + (size_t)(which == 1 ? 5 : 6) * UNIT) + (size_t)(u.pm * 4 + head) * 65536 + j;
#pragma unroll
                    for (int q = 0; q < 4; ++q) {
                        tb[(size_t)(d0 + q) * 256] = f2bf(lo0[q] * sc); tb[(size_t)(d0 + 4 + q) * 256] = f2bf(lo1[q] * sc);
                        tb[(size_t)(128 + d0 + q) * 256] = f2bf(hi0[q] * sc); tb[(size_t)(128 + d0 + 4 + q) * 256] = f2bf(hi1[q] * sc);
                    }
                }
            }
    }
};
struct EpiAB {
    static constexpr bool PERM = true, AFTER_DRAIN = false;
    unsigned char* ws; bf16_t* bl;
    const unsigned* waitw = nullptr; unsigned need = 0u; int fpm = -1, fpn = -1;
    __device__ __forceinline__ void operator()(const f32x4 (&acc)[2][2][4][2], const Unit& u, int wr, int wc, int fr, int fq) const {
        const int row0 = u.pm * 256 + wr * 64 + fr, c0 = wc * 32 + 8 * fq;
        if (waitw != nullptr && u.pm == fpm && u.pn == fpn) {
            for (unsigned spins = 0; spins < (1u << 22); ++spins) { if ((unsigned)__builtin_amdgcn_readfirstlane(__hip_atomic_load(waitw, __ATOMIC_RELAXED, __HIP_MEMORY_SCOPE_AGENT)) >= need) break; __builtin_amdgcn_s_sleep(2); }
            asm volatile("" ::: "memory");
        }
        const WtBuf wt = wt_make(ws);
        if (u.pn < 24) {
            const int g = u.pn >> 2; const int rg = 1 + g + (g >= 3 ? 1 : 0);
            bf16_t* base = (bf16_t*)(ws + (size_t)rg * UNIT) + (u.pn & 3) * 256 + c0;
#pragma unroll
            for (int ai = 0; ai < 2; ++ai)
#pragma unroll
                for (int m = 0; m < 4; ++m) { bf16_t* rowp = base + (size_t)(row0 + ai * 128 + m * 16) * DM;
#pragma unroll
                    for (int bj = 0; bj < 2; ++bj) wt_st16(wt, rowp + bj * 128, pack8(acc[ai][bj][m][0], acc[ai][bj][m][1])); }
        } else {
#pragma unroll
            for (int ai = 0; ai < 2; ++ai)
#pragma unroll
                for (int m = 0; m < 4; ++m) *(u32x4*)(bl + (size_t)(row0 + ai * 128 + m * 16) * 128 + c0) = pack8(acc[ai][0][m][0], acc[ai][0][m][1]);
        }
    }
};
struct EpiGate {
    static constexpr bool PERM = true, AFTER_DRAIN = false;
    const bf16_t* cv; bf16_t* la; bf16_t* lb; const float* gb; const float* lam;
    __device__ __forceinline__ void operator()(const f32x4 (&acc)[2][2][4][2], const Unit& u, int wr, int wc, int fr, int fq) const {
        const int row0 = u.pm * 256 + wr * 64 + fr, ch0 = (u.pn >> 1) * 256 + (u.pn & 1) * 128 + wc * 32 + 8 * fq;
        float sp[8], b0[8], b1[8];
#pragma unroll
        for (int j = 0; j < 8; ++j) { const float z = -lam[ch0 + j];
            sp[j] = -8.0f * (fmaxf(z, 0.f) + __builtin_amdgcn_logf(1.0f + fexp_(-fabsf(z))) * 0.6931471805599453f); b0[j] = gb[ch0 + j]; b1[j] = gb[DM + ch0 + j]; }
#pragma unroll
        for (int ai = 0; ai < 2; ++ai)
#pragma unroll
            for (int m = 0; m < 4; ++m) {
                const int row = row0 + ai * 128 + m * 16; const size_t o = (size_t)row * DM + ch0;
                f32x4 c0, c1; unpack8(*(const u32x4*)(cv + o), c0, c1);
                f32x4 A0, A1, B0, B1;
                const bool first = (row & (SEQ - 1)) == 0;
#pragma unroll
                for (int j = 0; j < 8; ++j) {
                    const float g0 = (j < 4 ? acc[ai][0][m][0][j & 3] : acc[ai][0][m][1][j & 3]) + b0[j];
                    const float g1 = (j < 4 ? acc[ai][1][m][0][j & 3] : acc[ai][1][m][1][j & 3]) + b1[j];
                    const float cvj = j < 4 ? c0[j & 3] : c1[j & 3];
                    const float log_a = fsigmoid_(g0) * sp[j];
                    float mult = __builtin_amdgcn_sqrtf(fmaxf(one_minus_exp_(2.0f * log_a), 0.f)); if (first) mult = 1.0f;
                    const float bb = mult * fsigmoid_(g1) * cvj;
                    if (j < 4) { A0[j & 3] = log_a; B0[j & 3] = bb; } else { A1[j & 3] = log_a; B1[j & 3] = bb; }
                }
                *(u32x4*)(la + o) = pack8(A0, A1); *(u32x4*)(lb + o) = pack8(B0, B1);
            }
    }
};
struct EpiPM {
    static constexpr bool PERM = true, AFTER_DRAIN = false;
    bf16_t* pm; const float* bias;
    __device__ __forceinline__ void operator()(const f32x4 (&acc)[2][2][4][2], const Unit& u, int wr, int wc, int fr, int fq) const {
        const int row0 = u.pm * 256 + wr * 64 + fr, c0 = wc * 32 + 8 * fq;
        bf16_t* base = pm + (size_t)(u.pn >> 2) * (UNIT / 2) + (u.pn & 3) * 256 + c0; const float* bp = bias + u.pn * 256 + c0;
#pragma unroll
        for (int bj = 0; bj < 2; ++bj) {
            const f32x4 bv0 = *(const f32x4*)(bp + bj * 128), bv1 = *(const f32x4*)(bp + bj * 128 + 4);
#pragma unroll
            for (int ai = 0; ai < 2; ++ai)
#pragma unroll
                for (int m = 0; m < 4; ++m) {
                    f32x4 v0 = acc[ai][bj][m][0] + bv0, v1 = acc[ai][bj][m][1] + bv1;
#pragma unroll
                    for (int j = 0; j < 4; ++j) { v0[j] = fsigmoid_(v0[j]); v1[j] = fsigmoid_(v1[j]); }
                    *(u32x4*)(base + (size_t)(row0 + ai * 128 + m * 16) * DM + bj * 128) = pack8(v0, v1);
                }
        }
    }
};
struct EpiMerge {
    static constexpr bool PERM = true, AFTER_DRAIN = false;
    const bf16_t* pm; bf16_t* mg;
    __device__ __forceinline__ void operator()(const f32x4 (&acc)[2][2][4][2], const Unit& u, int wr, int wc, int fr, int fq) const {
        const int row0 = u.pm * 256 + wr * 64 + fr, c0 = u.pn * 256 + wc * 32 + 8 * fq;
        const bf16_t* gp = pm + (size_t)u.z * (UNIT / 2);
#pragma unroll
        for (int ai = 0; ai < 2; ++ai)
#pragma unroll
            for (int m = 0; m < 4; ++m)
#pragma unroll
                for (int bj = 0; bj < 2; ++bj) {
                    const size_t o = (size_t)(row0 + ai * 128 + m * 16) * DM + c0 + bj * 128;
                    f32x4 g0, g1; unpack8(*(const u32x4*)(gp + o), g0, g1);
                    f32x4 v0 = g0 * acc[ai][bj][m][0], v1 = g1 * acc[ai][bj][m][1];
                    if (u.z > 0) { f32x4 p0, p1; unpack8(*(const u32x4*)(mg + o), p0, p1); v0 += p0; v1 += p1; }
                    *(u32x4*)(mg + o) = pack8(v0, v1);
                }
    }
};
struct EpiMerge6 {
    static constexpr bool PERM = true, AFTER_DRAIN = false;
    bf16_t* pm; bf16_t* mg; const float* bias;
    __device__ __forceinline__ void operator()(const f32x4 (&acc)[2][2][4][2], const Unit& u, int wr, int wc, int fr, int fq) const {
        const int row0 = u.pm * 256 + wr * 64 + fr, c0 = u.pn * 256 + wc * 32 + 8 * fq;
        if (u.z < 3) {
            bf16_t* gp = pm + (size_t)u.z * (UNIT / 2); const float* bp = bias + u.z * 1024 + c0;
#pragma unroll
            for (int bj = 0; bj < 2; ++bj) {
                const f32x4 bv0 = *(const f32x4*)(bp + bj * 128), bv1 = *(const f32x4*)(bp + bj * 128 + 4);
#pragma unroll
                for (int ai = 0; ai < 2; ++ai)
#pragma unroll
                    for (int m = 0; m < 4; ++m) {
                        f32x4 v0 = acc[ai][bj][m][0] + bv0, v1 = acc[ai][bj][m][1] + bv1;
#pragma unroll
                        for (int j = 0; j < 4; ++j) { v0[j] = fsigmoid_(v0[j]); v1[j] = fsigmoid_(v1[j]); }
                        *(u32x4*)(gp + (size_t)(row0 + ai * 128 + m * 16) * DM + c0 + bj * 128) = pack8(v0, v1);
                    }
            }
        } else {
            const bf16_t* gp = pm + (size_t)(u.z - 3) * (UNIT / 2);
#pragma unroll
            for (int ai = 0; ai < 2; ++ai)
#pragma unroll
                for (int m = 0; m < 4; ++m)
#pragma unroll
                    for (int bj = 0; bj < 2; ++bj) {
                        const size_t o = (size_t)(row0 + ai * 128 + m * 16) * DM + c0 + bj * 128;
                        f32x4 g0, g1; unpack8(*(const u32x4*)(gp + o), g0, g1);
                        f32x4 v0 = g0 * acc[ai][bj][m][0], v1 = g1 * acc[ai][bj][m][1];
                        if (u.z > 3) { f32x4 p0, p1; unpack8(*(const u32x4*)(mg + o), p0, p1); v0 += p0; v1 += p1; }
                        *(u32x4*)(mg + o) = pack8(v0, v1);
                    }
        }
    }
};
struct EpiOut {
    static constexpr bool PERM = false, AFTER_DRAIN = false;
    const float* xin; float* xout;
    __device__ __forceinline__ void operator()(const f32x4 (&acc)[2][2][4][2], const Unit& u, int wr, int wc, int fr, int fq) const {
        const int row0 = u.pm * 256 + wr * 64 + fr, col0 = u.pn * 256 + wc * 32 + 4 * fq;
#pragma unroll
        for (int ai = 0; ai < 2; ++ai)
#pragma unroll
            for (int m = 0; m < 4; ++m) { const size_t ro = (size_t)(row0 + ai * 128 + m * 16) * DM + col0;
#pragma unroll
                for (int bj = 0; bj < 2; ++bj)
#pragma unroll
                    for (int n = 0; n < 2; ++n) { const size_t o = ro + bj * 128 + n * 16; *(f32x4*)(xout + o) = *(const f32x4*)(xin + o) + acc[ai][bj][m][n]; } }
    }
};
struct EpiOutNorm {
    static constexpr bool PERM = false, AFTER_DRAIN = true;
    const float* xin; float* xout; bf16_t* hout; const float* nw; float* ssq; unsigned* ctr; int last;
    __device__ __forceinline__ void fused(f32x4 (&acc)[2][2][4][2], const Unit& u, int wr, int wc, int fr, int fq, LAS unsigned char* lds, int wid, int lane) const {
        LAS float* P = (LAS float*)lds;
        LAS float* RS = (LAS float*)(lds + 4096);
        const int col0 = u.pn * 256 + wc * 32 + 4 * fq, tid = wid * 64 + lane;
#pragma unroll
        for (int ai = 0; ai < 2; ++ai)
#pragma unroll
            for (int m = 0; m < 4; ++m) { const int i = wr * 64 + fr + ai * 128 + m * 16; const size_t ro = (size_t)(u.pm * 256 + i) * DM + col0; float sq = 0.f;
#pragma unroll
                for (int bj = 0; bj < 2; ++bj)
#pragma unroll
                    for (int n = 0; n < 2; ++n) { const size_t o = ro + bj * 128 + n * 16; const f32x4 v = *(const f32x4*)(xin + o) + acc[ai][bj][m][n]; acc[ai][bj][m][n] = v;
                        sq += (v[0] * v[0] + v[1] * v[1]) + (v[2] * v[2] + v[3] * v[3]); }
                sq += __shfl_xor(sq, 16); sq += __shfl_xor(sq, 32);
                if (fq == 0) P[i * 4 + wc] = sq; }
        asm volatile("s_waitcnt lgkmcnt(0)" ::: "memory"); __builtin_amdgcn_s_barrier(); asm volatile("" ::: "memory");
        if (tid < 256) { const f32x4 q = *(const LAS f32x4*)(P + tid * 4);
            __hip_atomic_store((unsigned*)(ssq + (size_t)u.pn * T_TOK + u.pm * 256 + tid), __float_as_uint((q[0] + q[1]) + (q[2] + q[3])), __ATOMIC_RELAXED, __HIP_MEMORY_SCOPE_AGENT); }
        asm volatile("s_waitcnt vmcnt(0)" ::: "memory"); __syncthreads();
        if (tid == 0) {
            __hip_atomic_fetch_add(ctr + u.pm, 1u, __ATOMIC_RELAXED, __HIP_MEMORY_SCOPE_AGENT);
            for (unsigned spins = 0; spins < (1u << 22); ++spins) { if (__hip_atomic_load(ctr + u.pm, __ATOMIC_RELAXED, __HIP_MEMORY_SCOPE_AGENT) >= 4u) break; __builtin_amdgcn_s_sleep(2); }
            __builtin_amdgcn_fence(__ATOMIC_ACQUIRE, "agent"); asm volatile("s_waitcnt vmcnt(0)" ::: "memory");
        }
        __syncthreads();
        if (tid < 256) { float t4 = 0.f;
#pragma unroll
            for (int k = 0; k < 4; ++k) t4 += ssq[(size_t)k * T_TOK + u.pm * 256 + tid];
            RS[tid] = rsqrtf(t4 * (1.0f / DM) + 1e-6f); }
        asm volatile("s_waitcnt lgkmcnt(0)" ::: "memory"); __builtin_amdgcn_s_barrier(); asm volatile("" ::: "memory");
        f32x4 wv[2][2];
#pragma unroll
        for (int bj = 0; bj < 2; ++bj)
#pragma unroll
            for (int n = 0; n < 2; ++n) wv[bj][n] = *(const f32x4*)(nw + col0 + bj * 128 + n * 16);
#pragma unroll
        for (int ai = 0; ai < 2; ++ai)
#pragma unroll
            for (int m = 0; m < 4; ++m) { const int i = wr * 64 + fr + ai * 128 + m * 16; const size_t ro = (size_t)(u.pm * 256 + i) * DM + col0; const float rs = RS[i];
#pragma unroll
                for (int bj = 0; bj < 2; ++bj)
#pragma unroll
                    for (int n = 0; n < 2; ++n) { const size_t o = ro + bj * 128 + n * 16; const f32x4 v = acc[ai][bj][m][n] * rs * wv[bj][n];
                        if (last) *(f32x4*)(xout + o) = v;
                        else { *(f32x4*)(xout + o) = acc[ai][bj][m][n]; pg8::u32x2 w; w.x = pg8::cvt_pk_bf16(v[0], v[1]); w.y = pg8::cvt_pk_bf16(v[2], v[3]); *(pg8::u32x2*)(hout + o) = w; } } }
    }
};

__device__ __forceinline__ void transpose_item(const float* W, int ldw, int K, bf16_t* WT, int k0, int n0, int orow0, LAS float* scr, int lane) {
    f32x4 v[8];
#pragma unroll
    for (int i = 0; i < 8; ++i) v[i] = *(const f32x4*)(W + (size_t)(k0 + 8 * i + (lane >> 3)) * ldw + n0 + (lane & 7) * 4);
#pragma unroll
    for (int i = 0; i < 8; ++i) { LAS float* d = scr + (8 * i + (lane >> 3)) * 33 + (lane & 7) * 4; d[0] = v[i][0]; d[1] = v[i][1]; d[2] = v[i][2]; d[3] = v[i][3]; }
    asm volatile("s_waitcnt lgkmcnt(0)" ::: "memory");
    const int c = lane & 7;
#pragma unroll
    for (int j = 0; j < 4; ++j) { const int n = (lane >> 3) + 8 * j; const LAS float* s = scr + (8 * c) * 33 + n;
        u32x4 o; o.x = pg8::cvt_pk_bf16(s[0 * 33], s[1 * 33]); o.y = pg8::cvt_pk_bf16(s[2 * 33], s[3 * 33]); o.z = pg8::cvt_pk_bf16(s[4 * 33], s[5 * 33]); o.w = pg8::cvt_pk_bf16(s[6 * 33], s[7 * 33]);
        *(u32x4*)(WT + (size_t)(orow0 + n) * K + k0 + 8 * c) = o; }
    asm volatile("s_waitcnt lgkmcnt(0)" ::: "memory");
}
__device__ void ph_weights(const Params& p, int l, int vb, int nvb, LAS unsigned char* lds, const unsigned* waitw, unsigned need) {
    const int wave = threadIdx.x >> 6, lane = threadIdx.x & 63;
    LAS float* scr = (LAS float*)(lds + wave * 16384);
    const int gw = vb * 8 + wave, NGW = nvb * 8;
    constexpr int I_IN = 16 * (NIN / 32), I_BR = 3 * 16 * 32, I_OUT = 16 * 32, I_G = 8 * 4 * 8, I_L = 2 * 32;
    bf16_t* win = (bf16_t*)MISC(p, OFF_WIN); bf16_t* wbr = (bf16_t*)MISC(p, OFF_WBR); bf16_t* wout = (bf16_t*)MISC(p, OFF_WOUT); bf16_t* wg = (bf16_t*)MISC(p, OFF_WG);
    for (int it = gw; it < I_IN + I_BR + I_OUT + I_G + I_L; it += NGW) {
        int r = it;
        if (r >= I_IN + I_BR + I_OUT + I_G) { r -= I_IN + I_BR + I_OUT + I_G; const int which = r >> 5, nb = r & 31;
            transpose_item((which ? p.a2 : p.w2) + (size_t)l * 64 * DM, DM, 64, (bf16_t*)MISC(p, which ? OFF_A2T : OFF_W2T), 0, nb * 32, nb * 32, scr, lane); continue; }
        if (r < I_IN) { const int kb = r / (NIN / 32), nb = r % (NIN / 32); transpose_item(p.w_in + (size_t)l * DM * NIN, NIN, DM, win, kb * 64, nb * 32, nb * 32, scr, lane); continue; } r -= I_IN;
        if (r < I_BR) { const int z = r / 512, q = r % 512, kb = q / 32, nb = q % 32; transpose_item(p.w_branch + ((size_t)l * 3 + z) * DM * DM, DM, DM, wbr + (size_t)z * DM * DM, kb * 64, nb * 32, nb * 32, scr, lane); continue; } r -= I_BR;
        if (r < I_OUT) { const int kb = r / 32, nb = r % 32;
            if (waitw != nullptr) {
                for (unsigned spins = 0; spins < (1u << 22); ++spins) { if ((unsigned)__builtin_amdgcn_readfirstlane(__hip_atomic_load(waitw, __ATOMIC_RELAXED, __HIP_MEMORY_SCOPE_AGENT)) >= need) break; __builtin_amdgcn_s_sleep(2); }
                asm volatile("" ::: "memory"); }
            transpose_item(p.w_out + (size_t)l * DM * DM, DM, DM, wout, kb * 64, nb * 32, nb * 32, scr, lane); continue; } r -= I_OUT;
        { const int gn = r / 32, q = r % 32, kb = q / 8, nb8 = q % 8; const int g = gn >> 2, nb = gn & 3; const int d0 = nb8 * 32;
          const int orow = (nb * 2 + (d0 >> 7)) * 256 + g * 128 + (d0 & 127);
          transpose_item(p.gate_w + ((size_t)l * 8 + gn) * 65536, 256, 256, wg, kb * 64, d0, orow, scr, lane); }
    }
}
__device__ void ph_rms(const float* xin, const float* w, bf16_t* H, int vb, int nvb) {
    const int wave = threadIdx.x >> 6, lane = threadIdx.x & 63;
    int row = vb * 8 + wave; if (row >= T_TOK) return;
    f32x4 nv[4];
#pragma unroll
    for (int j = 0; j < 4; ++j) nv[j] = ((const f32x4*)(xin + (size_t)row * DM) + lane)[64 * j];
    for (;;) {
        f32x4 v[4]; float s = 0.f;
#pragma unroll
        for (int j = 0; j < 4; ++j) { v[j] = nv[j]; s += (v[j][0] * v[j][0] + v[j][1] * v[j][1]) + (v[j][2] * v[j][2] + v[j][3] * v[j][3]); }
        const int nrow = row + nvb * 8;
        if (nrow < T_TOK) {
#pragma unroll
            for (int j = 0; j < 4; ++j) nv[j] = ((const f32x4*)(xin + (size_t)nrow * DM) + lane)[64 * j];
        }
        const float rs = rsqrtf(wave_sum(s) * (1.0f / DM) + 1e-6f);
        pg8::u32x2* o8 = (pg8::u32x2*)(H + (size_t)row * DM) + lane;
#pragma unroll
        for (int j = 0; j < 4; ++j) { const f32x4 wv = ((const f32x4*)w)[lane + 64 * j]; pg8::u32x2 o; o.x = pk2(v[j][0] * rs * wv[0], v[j][1] * rs * wv[1]); o.y = pk2(v[j][2] * rs * wv[2], v[j][3] * rs * wv[3]); o8[64 * j] = o; }
        if (nrow >= T_TOK) break;
        row = nrow;
    }
}
__device__ void ph_final(const Params& p, int vb, int nvb) {
    const int wave = threadIdx.x >> 6, lane = threadIdx.x & 63;
    for (int row = vb * 8 + wave; row < T_TOK; row += nvb * 8) {
        f32x4* xr = (f32x4*)(p.out + (size_t)row * DM) + lane;
        f32x4 v[4]; float s = 0.f;
#pragma unroll
        for (int j = 0; j < 4; ++j) { v[j] = xr[64 * j]; s += (v[j][0] * v[j][0] + v[j][1] * v[j][1]) + (v[j][2] * v[j][2] + v[j][3] * v[j][3]); }
        const float rs = rsqrtf(wave_sum(s) * (1.0f / DM) + 1e-6f);
#pragma unroll
        for (int j = 0; j < 4; ++j) { const f32x4 wv = ((const f32x4*)p.fnorm_w)[lane + 64 * j]; xr[64 * j] = v[j] * rs * wv; }
    }
}
__device__ void ph_rope_table(const Params& p, int vb, int nvb) {
    float2* tab = (float2*)MISC(p, OFF_ROPE);
    for (int i = vb * NT + threadIdx.x; i < SEQ * 128; i += nvb * NT) {
        const int pos = i >> 7, d = i & 127;
        const float lin = (float)d / 127.0f;
        const float invf = 1.0f / (float)pow(10000.0, (double)lin);
        const float ang = (float)pos * invf;
        double s, c; sincos((double)ang, &s, &c);
        tab[i] = make_float2((float)c, (float)s);
    }
}


__device__ __forceinline__ void ph_conv_fast(const Params& p, int l, int vb, int nvb) {
    const bf16_t* XA = REG(p, R_XA); bf16_t* CVb = REG(p, R_CVB);
    const float* cw = p.conv_w + (size_t)l * 4 * DM; const float* cb = p.conv_b + (size_t)l * DM;
    for (int it = vb * NT + threadIdx.x; it < (T_TOK / 16) * 128; it += nvb * NT) {
        const int cg8 = it & 127, tb = it >> 7; const int ch = cg8 * 8, t0 = tb * 16; const bool seq_start = (t0 & (SEQ - 1)) == 0;
        u32x4 raw[19];
#pragma unroll
        for (int j = 0; j < 19; ++j) raw[j] = (seq_start && j < 3) ? (u32x4){0u, 0u, 0u, 0u} : *(const u32x4*)(XA + (size_t)(t0 - 3 + j) * DM + ch);
        float w[4][8], bias[8];
#pragma unroll
        for (int j = 0; j < 4; ++j) { const f32x4 a = *(const f32x4*)(cw + j * DM + ch), b = *(const f32x4*)(cw + j * DM + ch + 4);
#pragma unroll
            for (int q = 0; q < 4; ++q) { w[j][q] = a[q]; w[j][4 + q] = b[q]; } }
        { const f32x4 a = *(const f32x4*)(cb + ch), b = *(const f32x4*)(cb + ch + 4);
#pragma unroll
          for (int q = 0; q < 4; ++q) { bias[q] = a[q]; bias[4 + q] = b[q]; } }
        f32x4 h[3][2];
#pragma unroll
        for (int j = 0; j < 3; ++j) unpack8(raw[j], h[j][0], h[j][1]);
#pragma unroll
        for (int t = 0; t < 16; ++t) {
            f32x4 x0, x1; unpack8(raw[3 + t], x0, x1);
            f32x4 o0, o1;
#pragma unroll
            for (int q = 0; q < 4; ++q) {
                o0[q] = bias[q] + w[0][q] * h[0][0][q] + w[1][q] * h[1][0][q] + w[2][q] * h[2][0][q] + w[3][q] * x0[q];
                o1[q] = bias[4 + q] + w[0][4 + q] * h[0][1][q] + w[1][4 + q] * h[1][1][q] + w[2][4 + q] * h[2][1][q] + w[3][4 + q] * x1[q];
            }
            wt16(CVb, CVb + (size_t)(t0 + t) * DM + ch, pack8(o0, o1));
            h[0][0] = h[1][0]; h[0][1] = h[1][1]; h[1][0] = h[2][0]; h[1][1] = h[2][1]; h[2][0] = x0; h[2][1] = x1;
        }
    }
}
__device__ __forceinline__ void lru_passA_item(const bf16_t* LA, const bf16_t* LB, float* AG, int tb, int cg8) {
    const int ch = cg8 * 8, t0 = tb * 32;
    float ls[8], hh[8];
#pragma unroll
    for (int q = 0; q < 8; ++q) { ls[q] = 0.f; hh[q] = 0.f; }
#pragma unroll 1
    for (int tq = 0; tq < 32; tq += 8) {
        u32x4 ra[8], rb[8];
#pragma unroll
        for (int t = 0; t < 8; ++t) { ra[t] = *(const u32x4*)(LA + (size_t)(t0 + tq + t) * DM + ch); rb[t] = *(const u32x4*)(LB + (size_t)(t0 + tq + t) * DM + ch); }
#pragma unroll
        for (int t = 0; t < 8; ++t) {
            f32x4 a0, a1, b0, b1; unpack8(ra[t], a0, a1); unpack8(rb[t], b0, b1);
#pragma unroll
            for (int q = 0; q < 4; ++q) { ls[q] += a0[q]; hh[q] = fexp_(a0[q]) * hh[q] + b0[q]; ls[4 + q] += a1[q]; hh[4 + q] = fexp_(a1[q]) * hh[4 + q] + b1[q]; }
        }
    }
    float* o = AG + (size_t)tb * DM + ch;
    *(f32x4*)o = (f32x4){ls[0], ls[1], ls[2], ls[3]}; *(f32x4*)(o + 4) = (f32x4){ls[4], ls[5], ls[6], ls[7]};
    float* o2 = o + (size_t)512 * DM;
    *(f32x4*)o2 = (f32x4){hh[0], hh[1], hh[2], hh[3]}; *(f32x4*)(o2 + 4) = (f32x4){hh[4], hh[5], hh[6], hh[7]};
}
__device__ void ph_lru_passA_own(const Params& p, const pg8::StaticOrder& S) {
    const bf16_t* LA = REG(p, R_LA); const bf16_t* LB = REG(p, R_LB); float* AG = (float*)MISC(p, OFF_AGG);
    Unit u;
    for (int i0 = 0; S.next(i0, u); i0 += 4) {
        const int sel = threadIdx.x >> 7, e = threadIdx.x & 127;
        if (S.next(i0 + sel, u)) lru_passA_item(LA, LB, AG, u.pm * 8 + (e >> 4), ((u.pn >> 1) * 256 + (u.pn & 1) * 128) / 8 + (e & 15));
    }
}
__device__ void ph_lru_passB(const Params& p, int vb, int nvb, LAS unsigned char* lds) {
    const float* __restrict__ AGL = (const float*)MISC(p, OFF_AGG); const float* __restrict__ AGB = AGL + (size_t)512 * DM; float* __restrict__ AGH = (float*)MISC(p, OFF_AGG) + (size_t)1024 * DM;
    LAS float* sh = (LAS float*)lds;
    for (int g = vb; g < 64; g += nvb) {
        const int chl = threadIdx.x & 31, seg = threadIdx.x >> 5; const int chain = g * 32 + chl; const int ch = chain & 1023, b = chain >> 10;
        const size_t o0 = (size_t)(b * 256 + seg * 16) * DM + ch;
        float la[16], lb[16];
#pragma unroll
        for (int i = 0; i < 16; ++i) { la[i] = AGL[o0 + (size_t)i * DM]; lb[i] = AGB[o0 + (size_t)i * DM]; }
        float LS = 0.f, HH = 0.f;
#pragma unroll
        for (int i = 0; i < 16; ++i) { LS += la[i]; HH = fexp_(la[i]) * HH + lb[i]; }
        sh[seg * 32 + chl] = LS; sh[512 + seg * 32 + chl] = HH;
        __syncthreads();
        float h = 0.f;
        for (int sgi = 0; sgi < seg; ++sgi) h = fexp_(sh[sgi * 32 + chl]) * h + sh[512 + sgi * 32 + chl];
#pragma unroll
        for (int i = 0; i < 16; ++i) { AGH[o0 + (size_t)i * DM] = h; h = fexp_(la[i]) * h + lb[i]; }
        __syncthreads();
    }
}
__device__ void ph_lru_passC(const Params& p, int vb, int nvb) {
    const bf16_t* LA = REG(p, R_LA); const bf16_t* LB = REG(p, R_LB); bf16_t* GA = REG(p, R_GA); const float* AG = (const float*)MISC(p, OFF_AGG);
    for (int it = vb * NT + threadIdx.x; it < (T_TOK / 32) * 128; it += nvb * NT) {
        const int cg8 = it & 127, tb = it >> 7; const int ch = cg8 * 8, t0 = tb * 32;
        float hh[8];
        { const float* hi = AG + (size_t)1024 * DM + (size_t)tb * DM + ch; const f32x4 a = *(const f32x4*)hi, b = *(const f32x4*)(hi + 4);
#pragma unroll
          for (int q = 0; q < 4; ++q) { hh[q] = a[q]; hh[4 + q] = b[q]; } }
#pragma unroll 1
        for (int tq = 0; tq < 32; tq += 4) {
            u32x4 ra[4], rb[4], rg[4];
#pragma unroll
            for (int t = 0; t < 4; ++t) { const size_t o = (size_t)(t0 + tq + t) * DM + ch; ra[t] = *(const u32x4*)(LA + o); rb[t] = *(const u32x4*)(LB + o); rg[t] = *(const u32x4*)(GA + o); }
#pragma unroll
            for (int t = 0; t < 4; ++t) {
                const size_t o = (size_t)(t0 + tq + t) * DM + ch;
                f32x4 a0, a1, b0, b1, g0, g1; unpack8(ra[t], a0, a1); unpack8(rb[t], b0, b1); unpack8(rg[t], g0, g1);
                f32x4 y0, y1;
#pragma unroll
                for (int q = 0; q < 4; ++q) { hh[q] = fexp_(a0[q]) * hh[q] + b0[q]; y0[q] = hh[q] * fsilu_(g0[q]); hh[4 + q] = fexp_(a1[q]) * hh[4 + q] + b1[q]; y1[q] = hh[4 + q] * fsilu_(g1[q]); }
                wt16(GA, GA + o, pack8(y0, y1));
            }
        }
    }
}


#define R_KT 5
#define R_VT 6
#define R_KV 7
#define R_PS 8
__device__ __forceinline__ float ret_log2g(int h) { return log2f(1.0f - exp2f(-5.0f - (float)h)); }
struct LoraOrder {
    int G, c;
    __device__ __forceinline__ bool next(int i, Unit& u) const { const int id = i * G + c; if (id >= 64) return false; u.pm = id; u.pn = 24; u.z = 0; return true; }
};
struct UnitOrder {
    int G, c, n;
    __device__ __forceinline__ bool next(int i, Unit& u) const { const int id = i * G + c; if (id >= n) return false; u.pm = 0; u.pn = 0; u.z = id; return true; }
};
__device__ void ph_ret_transpose(const Params& p, int vb, int nvb, LAS unsigned char* lds) {
    const int wave = __builtin_amdgcn_readfirstlane(threadIdx.x >> 6), lane = threadIdx.x & 63;
    LAS bf16_t* tl = (LAS bf16_t*)(lds + wave * 16384);
    const bf16_t* CK = REG(p, R_CK); const bf16_t* CV = REG(p, R_CV); bf16_t* KT = REG(p, R_KT); bf16_t* VT = REG(p, R_VT);
    for (int z = vb; z < 256; z += nvb)
      for (int s32 = wave; s32 < 32; s32 += 8) {
        const int sub = s32 & 15, which = s32 >> 4; const int jt = sub >> 2, dt = sub & 3, h = z & 3, bn = z >> 2;
        const bf16_t* src = (which ? CV : CK) + (size_t)(bn * 256 + jt * 64 + lane) * DM + h * 256 + dt * 64;
        const float sc = which ? 1.0f : exp2f(ret_log2g(h) * (float)(255 - (jt * 64 + lane)));
#pragma unroll
        for (int q = 0; q < 8; ++q) { f32x4 a, b; unpack8(*(const u32x4*)(src + q * 8), a, b); a = a * sc; b = b * sc; *(LAS u32x4*)(tl + lane * 72 + q * 8) = pack8(a, b); }
        asm volatile("s_waitcnt lgkmcnt(0)" ::: "memory");
        bf16_t* dst = (which ? VT : KT) + (size_t)z * 65536 + (size_t)(dt * 64 + lane) * 256 + jt * 64;
#pragma unroll
        for (int q = 0; q < 8; ++q) { u32x4 w;
            unsigned e[8];
#pragma unroll
            for (int k = 0; k < 8; ++k) e[k] = tl[(q * 8 + k) * 72 + lane];
            w.x = e[0] | (e[1] << 16); w.y = e[2] | (e[3] << 16); w.z = e[4] | (e[5] << 16); w.w = e[6] | (e[7] << 16);
            *(u32x4*)(dst + q * 8) = w; }
        asm volatile("s_waitcnt lgkmcnt(0)" ::: "memory");
      }
}
__device__ __forceinline__ void wg_self_visible() {
    asm volatile("s_waitcnt vmcnt(0)" ::: "memory"); __syncthreads();
    if (threadIdx.x == 0) { __builtin_amdgcn_fence(__ATOMIC_ACQUIRE, "agent"); asm volatile("s_waitcnt vmcnt(0)" ::: "memory"); }
    __syncthreads();
}
struct GRetKV { const char* VT; const char* KT; int K, lda, ldb;
    __device__ __forceinline__ const char* aptr(const Unit& u, int t) const { return VT + ((size_t)u.z * 65536 + (size_t)t * 64) * 2; }
    __device__ __forceinline__ const char* bptr(const Unit& u, int t) const { return KT + ((size_t)u.z * 65536 + (size_t)t * 64) * 2; } };
struct EpiKV { static constexpr bool PERM = true, AFTER_DRAIN = false; bf16_t* kv;
    __device__ __forceinline__ void operator()(const f32x4 (&acc)[2][2][4][2], const Unit& u, int wr, int wc, int fr, int fq) const {
        bf16_t* base = kv + (size_t)u.z * 65536 + (size_t)(wr * 64 + fr) * 256 + wc * 32 + 8 * fq;
#pragma unroll
        for (int ai = 0; ai < 2; ++ai)
#pragma unroll
            for (int m = 0; m < 4; ++m)
#pragma unroll
                for (int bj = 0; bj < 2; ++bj) *(u32x4*)(base + (size_t)(ai * 128 + m * 16) * 256 + bj * 128) = pack8(acc[ai][bj][m][0], acc[ai][bj][m][1]); } };
__device__ void ph_ret_scan(const Params& p, int vb, int nvb) {
    bf16_t* KV = REG(p, R_KV);
    const int lane = threadIdx.x & 63, half = lane >> 5;
    for (int it2 = vb * NT + threadIdx.x; it2 < 2 * 8 * 8192; it2 += nvb * NT) {
        const int it = (it2 >> 6) * 32 + (lane & 31);
        const int bh = it >> 13, off = (it & 8191) * 8; const int h = bh & 3, b = bh >> 2;
        const float cd = exp2f(ret_log2g(h) * 256.0f);
        bf16_t* base = KV + (size_t)((b * 32 + half * 16) * 4 + h) * 65536 + off;
        u32x4 raw[16];
#pragma unroll
        for (int i = 0; i < 16; ++i) raw[i] = *(const u32x4*)(base + (size_t)i * 4 * 65536);
        f32x4 s0 = (f32x4){0.f, 0.f, 0.f, 0.f}, s1 = s0;
#pragma unroll
        for (int i = 0; i < 16; ++i) { f32x4 a, c; unpack8(raw[i], a, c); s0 = s0 * cd + a; s1 = s1 * cd + c; }
        f32x4 c0, c1;
#pragma unroll
        for (int k = 0; k < 4; ++k) { c0[k] = __shfl(s0[k], lane & 31); c1[k] = __shfl(s1[k], lane & 31); }
        if (half == 0) { c0 = (f32x4){0.f, 0.f, 0.f, 0.f}; c1 = c0; }
        s0 = c0; s1 = c1;
#pragma unroll
        for (int i = 0; i < 16; ++i) { f32x4 a, c; unpack8(raw[i], a, c); wt16(KV, base + (size_t)i * 4 * 65536, pack8(s0, s1)); s0 = s0 * cd + a; s1 = s1 * cd + c; }
    }
}
struct GRetS { const char* Q; const char* Kk; int K, lda, ldb;
    __device__ __forceinline__ const char* aptr(const Unit& u, int t) const { return Q + ((size_t)(u.z >> 2) * 256 * 1024 + (size_t)(u.z & 3) * 256 + (size_t)t * 64) * 2; }
    __device__ __forceinline__ const char* bptr(const Unit& u, int t) const { return Kk + ((size_t)(u.z >> 2) * 256 * 1024 + (size_t)(u.z & 3) * 256 + (size_t)t * 64) * 2; } };
struct EpiScore { static constexpr bool PERM = true, AFTER_DRAIN = false; bf16_t* ps;
    __device__ __forceinline__ void operator()(const f32x4 (&acc)[2][2][4][2], const Unit& u, int wr, int wc, int fr, int fq) const {
        const int h = u.z & 3; const float l2g = ret_log2g(h);
        bf16_t* base = ps + (size_t)(u.z >> 2) * 256 * 1024 + h * 256;
        const int i0 = wr * 64 + fr, j0 = wc * 32 + 8 * fq;
        float dk[2][8];
#pragma unroll
        for (int bj = 0; bj < 2; ++bj)
#pragma unroll
            for (int k = 0; k < 8; ++k) dk[bj][k] = exp2f(-l2g * (float)(j0 + bj * 128 + k + 1));
#pragma unroll
        for (int ai = 0; ai < 2; ++ai)
#pragma unroll
            for (int m = 0; m < 4; ++m) { const int i = i0 + ai * 128 + m * 16;
#pragma unroll
                for (int bj = 0; bj < 2; ++bj) { f32x4 v0, v1;
#pragma unroll
                    for (int k = 0; k < 4; ++k) { const int j = j0 + bj * 128 + k; v0[k] = j <= i ? acc[ai][bj][m][0][k] * dk[bj][k] : 0.f; v1[k] = (j + 4) <= i ? acc[ai][bj][m][1][k] * dk[bj][4 + k] : 0.f; }
                    *(u32x4*)(base + (size_t)i * 1024 + j0 + bj * 128) = pack8(v0, v1); } } } };
struct GRetO { const char* PS; const char* Q; const char* VT; const char* SN; int K, lda, ldb;
    __device__ __forceinline__ const char* aptr(const Unit& u, int t) const { const size_t o = (size_t)(u.z >> 2) * 256 * 1024 + (size_t)(u.z & 3) * 256; return t < 4 ? PS + (o + (size_t)t * 64) * 2 : Q + (o + (size_t)(t - 4) * 64) * 2; }
    __device__ __forceinline__ const char* bptr(const Unit& u, int t) const { const size_t o = (size_t)u.z * 65536; return t < 4 ? VT + (o + (size_t)t * 64) * 2 : SN + (o + (size_t)(t - 4) * 64) * 2; } };
struct EpiRet { static constexpr bool PERM = true, AFTER_DRAIN = true; bf16_t* cg;
    __device__ __forceinline__ void fused(f32x4 (&acc)[2][2][4][2], const Unit& u, int wr, int wc, int fr, int fq, LAS unsigned char* lds, int wid, int lane) const {
        const int h = u.z & 3; const float l2g = ret_log2g(h);
        LAS float* P = (LAS float*)lds;
        float mean[2][4];
#pragma unroll
        for (int ai = 0; ai < 2; ++ai)
#pragma unroll
            for (int m = 0; m < 4; ++m) { const int i = wr * 64 + fr + ai * 128 + m * 16; const float sc = exp2f(l2g * (float)(i + 1)); float s = 0.f;
#pragma unroll
                for (int bj = 0; bj < 2; ++bj)
#pragma unroll
                    for (int n = 0; n < 2; ++n) { acc[ai][bj][m][n] = acc[ai][bj][m][n] * sc; const f32x4 x = acc[ai][bj][m][n]; s += (x[0] + x[1]) + (x[2] + x[3]); }
                s += __shfl_xor(s, 16); s += __shfl_xor(s, 32);
                if (fq == 0) P[i * 4 + wc] = s; }
        asm volatile("s_waitcnt lgkmcnt(0)" ::: "memory"); __builtin_amdgcn_s_barrier(); asm volatile("" ::: "memory");
#pragma unroll
        for (int ai = 0; ai < 2; ++ai)
#pragma unroll
            for (int m = 0; m < 4; ++m) { const int i = wr * 64 + fr + ai * 128 + m * 16; const f32x4 q = *(const LAS f32x4*)(P + i * 4); mean[ai][m] = ((q[0] + q[1]) + (q[2] + q[3])) * (1.0f / 256.0f); }
        asm volatile("s_waitcnt lgkmcnt(0)" ::: "memory"); __builtin_amdgcn_s_barrier(); asm volatile("" ::: "memory");
#pragma unroll
        for (int ai = 0; ai < 2; ++ai)
#pragma unroll
            for (int m = 0; m < 4; ++m) { const int i = wr * 64 + fr + ai * 128 + m * 16; float s = 0.f;
#pragma unroll
                for (int bj = 0; bj < 2; ++bj)
#pragma unroll
                    for (int n = 0; n < 2; ++n) { const f32x4 d = acc[ai][bj][m][n] - mean[ai][m]; s += (d[0] * d[0] + d[1] * d[1]) + (d[2] * d[2] + d[3] * d[3]); }
                s += __shfl_xor(s, 16); s += __shfl_xor(s, 32);
                if (fq == 0) P[i * 4 + wc] = s; }
        asm volatile("s_waitcnt lgkmcnt(0)" ::: "memory"); __builtin_amdgcn_s_barrier(); asm volatile("" ::: "memory");
        bf16_t* base = cg + (size_t)(u.z >> 2) * 256 * 1024 + h * 256 + wc * 32 + 8 * fq;
#pragma unroll
        for (int ai = 0; ai < 2; ++ai)
#pragma unroll
            for (int m = 0; m < 4; ++m) { const int i = wr * 64 + fr + ai * 128 + m * 16; const f32x4 q = *(const LAS f32x4*)(P + i * 4);
                const float rstd = rsqrtf(((q[0] + q[1]) + (q[2] + q[3])) * (1.0f / 256.0f) + 1e-5f);
#pragma unroll
                for (int bj = 0; bj < 2; ++bj) { bf16_t* gp = base + (size_t)i * 1024 + bj * 128; f32x4 g0, g1; unpack8(*(const u32x4*)gp, g0, g1); f32x4 y0, y1;
#pragma unroll
                    for (int k = 0; k < 4; ++k) { y0[k] = (acc[ai][bj][m][0][k] - mean[ai][m]) * rstd * fsilu_(g0[k]); y1[k] = (acc[ai][bj][m][1][k] - mean[ai][m]) * rstd * fsilu_(g1[k]); }
                    *(u32x4*)gp = pack8(y0, y1); } }
        asm volatile("s_waitcnt lgkmcnt(0)" ::: "memory"); __builtin_amdgcn_s_barrier(); asm volatile("" ::: "memory");
    }
};
__device__ __forceinline__ void ph_ret_out_fast(const Params& p, int vb, int nvb, LAS unsigned char* lds) {
    UnitOrder S{nvb, vb, 256};
    { GRetS g{(const char*)REG(p, R_CQ), (const char*)REG(p, R_CK), 256, DM, DM}; EpiScore e{REG(p, R_PS)};
      pg8::gemm_phase<GRetS, EpiScore, UnitOrder, true, true>(lds, g, S, e); }
    asm volatile("s_waitcnt vmcnt(0)" ::: "memory"); __syncthreads();
    if (threadIdx.x == 0) { __builtin_amdgcn_fence(__ATOMIC_ACQUIRE, "agent"); asm volatile("s_waitcnt vmcnt(0)" ::: "memory"); }
    __syncthreads();
    { GRetO g{(const char*)REG(p, R_PS), (const char*)REG(p, R_CQ), (const char*)REG(p, R_VT), (const char*)REG(p, R_KV), 512, DM, 256}; EpiRet e{REG(p, R_CG)};
      pg8::gemm_phase<GRetO, EpiRet, UnitOrder, true, true>(lds, g, S, e); }
}

__device__ __forceinline__ float ret_logg(int h) { return (float)log1p(-exp2(-5.0 - (double)h)); }
__device__ void ph_ret_scores(const Params& p, int vb, int nvb) {
    const bf16_t* Q = REG(p, R_CQ); const bf16_t* Kb = REG(p, R_CK); float* SC = (float*)REG(p, R_SC);
    const size_t n = (size_t)512 * 128 * 128;
    for (size_t idx = (size_t)vb * NT + threadIdx.x; idx < n; idx += (size_t)nvb * NT) {
        const int j = (int)(idx & 127), i = (int)((idx >> 7) & 127); const int u = (int)(idx >> 14);
        const int h = u & 3, bn = u >> 2;
        float v = 0.f;
        if (j <= i) {
            const bf16_t* qp = Q + (size_t)(bn * 128 + i) * DM + h * 256; const bf16_t* kp = Kb + (size_t)(bn * 128 + j) * DM + h * 256;
            float s = 0.f;
            for (int d = 0; d < 256; ++d) s += bf2f(qp[d]) * bf2f(kp[d]);
            v = s * expf(ret_logg(h) * (float)(i - j));
        }
        SC[idx] = v;
    }
}
__device__ void ph_ret_states(const Params& p, int vb, int nvb) {
    const bf16_t* Kb = REG(p, R_CK); const bf16_t* V = REG(p, R_CV); bf16_t* SN = REG(p, R_SN);
    const int n = 8 * 256 * 256;
    for (int idx = vb * NT + threadIdx.x; idx < n; idx += nvb * NT) {
        const int e = idx & 255, d = (idx >> 8) & 255, bh = idx >> 16; const int h = bh & 3, b = bh >> 2;
        const float lg = ret_logg(h); const float cd = expf(lg * 128.0f);
        float st = 0.f;
        for (int c = 0; c < 64; ++c) {
            SN[((size_t)((b * 64 + c) * 4 + h) * 256 + d) * 256 + e] = f2bf(st);
            float acc = 0.f;
            const size_t t0 = (size_t)b * SEQ + c * 128;
            for (int j = 0; j < 128; ++j) acc += bf2f(Kb[(t0 + j) * DM + h * 256 + d]) * expf(lg * (float)(127 - j)) * bf2f(V[(t0 + j) * DM + h * 256 + e]);
            st = st * cd + acc;
        }
    }
}
__device__ void ph_ret_out(const Params& p, int vb, int nvb, LAS float* red) {
    const bf16_t* Q = REG(p, R_CQ); const bf16_t* V = REG(p, R_CV); const bf16_t* SN = REG(p, R_SN); const float* SC = (const float*)REG(p, R_SC);
    bf16_t* G = REG(p, R_CG);
    const int e = threadIdx.x & 255, half = threadIdx.x >> 8;
    for (int it = vb; it < T_TOK * 2; it += nvb) {
        const int u = it * 2 + half;
        const int h = u & 3, t = u >> 2; const int i = t & 127, bn = t >> 7;
        const float* sc = SC + ((size_t)(bn * 4 + h) * 128 + i) * 128;
        float o = 0.f;
        for (int j = 0; j <= i; ++j) o += sc[j] * bf2f(V[(size_t)(bn * 128 + j) * DM + h * 256 + e]);
        const float qd = expf(ret_logg(h) * (float)(i + 1));
        const bf16_t* qp = Q + (size_t)t * DM + h * 256; const bf16_t* sn = SN + (size_t)(bn * 4 + h) * 65536 + e;
        float cr = 0.f;
        for (int d = 0; d < 256; ++d) cr += bf2f(qp[d]) * bf2f(sn[(size_t)d * 256]);
        o += cr * qd;
        const float mean = half_sum(o, red) * (1.0f / 256.0f);
        const float dv = o - mean;
        const float var = half_sum(dv * dv, red) * (1.0f / 256.0f);
        const float y = dv * rsqrtf(var + 1e-5f);
        const size_t gi = (size_t)t * DM + h * 256 + e;
        G[gi] = f2bf(y * siluf_(bf2f(G[gi])));
    }
}
__device__ void ph_conv(const Params& p, int l, int vb, int nvb) {
    const bf16_t* XA = REG(p, R_XA); bf16_t* CVb = REG(p, R_CVB);
    const float* cw = p.conv_w + (size_t)l * 4 * DM; const float* cb = p.conv_b + (size_t)l * DM;
    const size_t n = (size_t)T_TOK * DM;
    for (size_t idx = (size_t)vb * NT + threadIdx.x; idx < n; idx += (size_t)nvb * NT) {
        const int ch = (int)(idx & 1023); const int t = (int)(idx >> 10); const int s = t & (SEQ - 1);
        float acc = cb[ch];
#pragma unroll
        for (int j = 0; j < 4; ++j) { const int ss = s - 3 + j; if (ss >= 0) acc += cw[j * DM + ch] * bf2f(XA[(size_t)(t - 3 + j) * DM + ch]); }
        CVb[idx] = f2bf(acc);
    }
}
__device__ void ph_lru_scan(const Params& p, int vb, int nvb) {
    const bf16_t* LA = REG(p, R_LA); const bf16_t* LB = REG(p, R_LB); bf16_t* GA = REG(p, R_GA);
    for (int idx = vb * NT + threadIdx.x; idx < 2 * DM; idx += nvb * NT) {
        const int ch = idx & 1023, b = idx >> 10;
        float h = 0.f;
        for (int s = 0; s < SEQ; ++s) {
            const size_t i = ((size_t)b * SEQ + s) * DM + ch;
            h = expf(bf2f(LA[i])) * h + bf2f(LB[i]);
            GA[i] = f2bf(h * siluf_(bf2f(GA[i])));
        }
    }
}
__device__ void ph_rwkv_prep(const Params& p, int l, int vb, int nvb) {
    const bf16_t* BL = (const bf16_t*)MISC(p, OFF_BL); bf16_t* LD = REG(p, R_LD); bf16_t* AA = REG(p, R_AA);
    const float* mu = p.mu + (size_t)l * 4224 + 4096; const float* w2 = p.w2 + (size_t)l * 64 * DM; const float* a2 = p.a2 + (size_t)l * 64 * DM;
    const float* w0 = p.w0 + (size_t)l * DM; const float* a0 = p.a0 + (size_t)l * DM;
    const size_t n = (size_t)T_TOK * DM;
    for (size_t idx = (size_t)vb * NT + threadIdx.x; idx < n; idx += (size_t)nvb * NT) {
        const int ch = (int)(idx & 1023); const int t = (int)(idx >> 10); const bool first = (t & (SEQ - 1)) == 0;
        const bf16_t* cur = BL + (size_t)t * 128; const bf16_t* prv = cur - 128;
        float dw = 0.f, da = 0.f;
        for (int j = 0; j < 64; ++j) {
            const float c0 = bf2f(cur[j]), p0 = first ? 0.f : bf2f(prv[j]);
            const float c1 = bf2f(cur[64 + j]), p1 = first ? 0.f : bf2f(prv[64 + j]);
            const float wl = c0 + (p0 - c0) * mu[j], al = c1 + (p1 - c1) * mu[64 + j];
            dw += tanhf(wl) * w2[(size_t)j * DM + ch]; da += al * a2[(size_t)j * DM + ch];
        }
        const float w_log = -softplusf_(-(w0[ch] + dw)) - 0.5f;
        LD[idx] = f2bf(-expf(w_log));
        AA[idx] = f2bf(sigmoidf_(a0[ch] + da));
    }
}
__device__ void ph_rwkv_rec(const Params& p, int l, int vb, int nvb, LAS float* smem) {
    const int wave = threadIdx.x >> 6, lane = threadIdx.x & 63, pr_ = wave >> 1, hw = wave & 1;
    LAS float* sh = smem + pr_ * 8 * 64;
    const bf16_t* BR = REG(p, R_BR); const bf16_t* BK = REG(p, R_BK); const bf16_t* BV = REG(p, R_BV); bf16_t* BG = REG(p, R_BG);
    const bf16_t* LD = REG(p, R_LD); const bf16_t* AA = REG(p, R_AA);
    for (int ub = vb; ub < 8; ub += nvb) {
        const int unit = ub * 4 + pr_; const int h = unit & 15, b = unit >> 4; const int ch = h * 64 + lane;
        const float* mu = p.mu + (size_t)l * 4224;
        const float mu_r = mu[ch], mu_k = mu[DM + ch], mu_v = mu[2 * DM + ch], mu_g = mu[3 * DM + ch];
        const float kk_w = p.k_k[(size_t)l * DM + ch], ka_w = p.k_a[(size_t)l * DM + ch], rk_w = p.r_k[(size_t)l * DM + ch];
        const float ln_w = p.lnx_w[(size_t)l * DM + ch], ln_b = p.lnx_b[(size_t)l * DM + ch];
        const int row = hw * 32 + (lane >> 1), kh0 = (lane & 1) * 32;
        float st[32];
#pragma unroll
        for (int k = 0; k < 32; ++k) st[k] = 0.f;
        float pr = 0.f, pk = 0.f, pv = 0.f, pg = 0.f;
        for (int s = 0; s < SEQ; ++s) {
            const size_t i = ((size_t)b * SEQ + s) * DM + ch;
            const float cr = bf2f(BR[i]), ck = bf2f(BK[i]), cv = bf2f(BV[i]), cgv = bf2f(BG[i]);
            const float r = cr + (pr - cr) * mu_r, k = ck + (pk - ck) * mu_k, v = cv + (pv - cv) * mu_v, g = cgv + (pg - cgv) * mu_g;
            pr = cr; pk = ck; pv = cv; pg = cgv;
            const float w = expf(bf2f(LD[i])), a = bf2f(AA[i]);
            const float kkc = k * kk_w;
            const float nrm = sqrtf(wave_sum(kkc * kkc));
            const float kk = kkc / fmaxf(nrm, 1e-12f);
            const float kh = k * (1.0f + (a - 1.0f) * ka_w);
            const float bonus_s = wave_sum(r * kh * rk_w);
            __syncthreads();
            if (hw == 0) { sh[lane] = r; sh[64 + lane] = w; sh[128 + lane] = kh; sh[192 + lane] = kk; sh[256 + lane] = kk * a; sh[320 + lane] = v; }
            __syncthreads();
            const float vr = sh[320 + row];
            float sa = 0.f;
#pragma unroll
            for (int kx = 0; kx < 32; ++kx) sa -= st[kx] * sh[192 + kh0 + kx];
            sa += __shfl_xor(sa, 1);
            float y = 0.f;
#pragma unroll
            for (int kx = 0; kx < 32; ++kx) { st[kx] = st[kx] * sh[64 + kh0 + kx] + sa * sh[256 + kh0 + kx] + vr * sh[128 + kh0 + kx]; y += st[kx] * sh[kh0 + kx]; }
            y += __shfl_xor(y, 1);
            if ((lane & 1) == 0) sh[384 + row] = y;
            __syncthreads();
            const float yc = sh[384 + lane];
            const float mean = wave_sum(yc) * (1.0f / 64.0f);
            const float dv = yc - mean;
            const float var = wave_sum(dv * dv) * (1.0f / 64.0f);
            const float yn = dv * rsqrtf(var + 64e-5f) * ln_w + ln_b;
            if (hw == 0) BG[i] = f2bf((yn + bonus_s * v) * siluf_(g));
        }
    }
}


#if defined(DEBUG_CHECK)
#define OFF_CK ((OFF_END + 255ull) & ~255ull)
__device__ __forceinline__ unsigned hash_u(unsigned x) { x ^= x >> 16; x *= 0x7feb352dU; x ^= x >> 15; x *= 0x846ca68bU; x ^= x >> 16; return x; }
__device__ __forceinline__ void ck_add(float* slot, float e2, float r2) {
    e2 = wave_sum(e2); r2 = wave_sum(r2);
    if ((threadIdx.x & 63) == 0) { atomicAdd(slot, e2); atomicAdd(slot + 1, r2); }
}
__device__ __forceinline__ float dot_bf_f32(const bf16_t* a, const float* w, int ldw, int K) { float s = 0.f; for (int k = 0; k < K; ++k) s += bf2f(a[k]) * w[(size_t)k * ldw]; return s; }
__device__ __forceinline__ void check_phase(const Params& p, int l, int ph, int vb, int nvb) {
    if (vb >= 32) return;
    float* slot = (float*)MISC(p, OFF_CK) + (l * 16 + ph) * 2;
    const unsigned sid = (unsigned)(vb * NT + threadIdx.x);
    const unsigned h1 = hash_u(sid * 2654435761u + 12345u + (unsigned)(l * 16 + ph)), h2 = hash_u(h1 + 0x9e3779b9u);
    const int r = (int)(h1 & 16383);
    const float* win = p.w_in + (size_t)l * DM * NIN;
    const bf16_t* H = REG(p, R_H) + (size_t)r * DM;
    float e2 = 0.f, r2 = 0.f;
    switch (ph) {
    case 0: {
        const int c = (int)(h2 & 1023); const float* xin = l == 0 ? p.x : p.out;
        float ss = 0.f; for (int k = 0; k < DM; ++k) { const float v = xin[(size_t)r * DM + k]; ss += v * v; }
        const float ref = bf2f(f2bf(xin[(size_t)r * DM + c] * rsqrtf(ss * (1.0f / DM) + 1e-6f) * p.norm_w[(size_t)l * DM + c]));
        const float got = bf2f(H[c]); e2 += (got - ref) * (got - ref); r2 += ref * ref;
        const int n = (int)(h2 % NIN), k = (int)((h2 >> 16) & 1023);
        const float wr = bf2f(f2bf(win[(size_t)k * NIN + n])), wg = bf2f(((const bf16_t*)MISC(p, OFF_WIN))[(size_t)n * DM + k]);
        e2 += (wr - wg) * (wr - wg); r2 += wr * wr;
        const int z = (int)(h2 % 3), n2 = (int)((h2 >> 8) & 1023);
        const float br = bf2f(f2bf(p.w_branch[((size_t)l * 3 + z) * DM * DM + (size_t)k * DM + n2])), bg = bf2f(((const bf16_t*)MISC(p, OFF_WBR))[((size_t)z * DM + n2) * DM + k]);
        e2 += (br - bg) * (br - bg); r2 += br * br;
        const float orf = bf2f(f2bf(p.w_out[(size_t)l * DM * DM + (size_t)k * DM + n2])), og = bf2f(((const bf16_t*)MISC(p, OFF_WOUT))[(size_t)n2 * DM + k]);
        e2 += (orf - og) * (orf - og); r2 += orf * orf;
    } break;
    case 1: {
        const int which = (int)(h2 & 3), head = (int)((h2 >> 2) & 3), d = (int)((h2 >> 4) & 127);
        const int cl = head * 256 + d, chh = cl + 128;
        float lo = dot_bf_f32(H, win + 6272 + which * 1024 + cl, NIN, DM), hi = dot_bf_f32(H, win + 6272 + which * 1024 + chh, NIN, DM);
        if (which < 2) { const float2 cs = ((const float2*)MISC(p, OFF_ROPE))[(size_t)(r & (SEQ - 1)) * 128 + d]; const float a = lo * cs.x - hi * cs.y, b = lo * cs.y + hi * cs.x; const float sc = which == 1 ? 0.0625f : 1.f; lo = a * sc; hi = b * sc; }
        const bf16_t* o = REG(p, R_CQ + which) + (size_t)r * DM;
        const float g0 = bf2f(o[cl]), g1 = bf2f(o[chh]);
        e2 += (g0 - lo) * (g0 - lo) + (g1 - hi) * (g1 - hi); r2 += lo * lo + hi * hi;
    } break;
    case 5: {
        const int g = (int)(h2 % 6), c = (int)((h2 >> 8) & 1023); const int rg = 1 + g + (g >= 3 ? 1 : 0);
        const float ref = dot_bf_f32(H, win + g * 1024 + c, NIN, DM); const float got = bf2f(REG(p, rg)[(size_t)r * DM + c]);
        e2 += (got - ref) * (got - ref); r2 += ref * ref;
        const int c2 = (int)((h2 >> 20) & 127);
        const float ref2 = dot_bf_f32(H, win + 6144 + c2, NIN, DM); const float got2 = bf2f(((const bf16_t*)MISC(p, OFF_BL))[(size_t)r * 128 + c2]);
        e2 += (got2 - ref2) * (got2 - ref2); r2 += ref2 * ref2;
    } break;
    case 7: {
        const int ch = (int)(h2 & 1023), nb = ch >> 8, d = ch & 255;
        const bf16_t* cp = REG(p, R_CVB) + (size_t)r * DM + nb * 256;
        const float* gw = p.gate_w + (size_t)l * 8 * 65536;
        float g0 = p.gate_b[(size_t)l * 2 * DM + ch], g1 = p.gate_b[(size_t)l * 2 * DM + DM + ch];
        for (int c = 0; c < 256; ++c) { const float cv = bf2f(cp[c]); g0 += cv * gw[((size_t)(0 * 4 + nb) * 256 + c) * 256 + d]; g1 += cv * gw[((size_t)(1 * 4 + nb) * 256 + c) * 256 + d]; }
        const float log_a = -8.0f * sigmoidf_(g0) * softplusf_(-p.lam[(size_t)l * DM + ch]);
        float mult = sqrtf(fmaxf(-expm1f(2.0f * log_a), 0.f)); if ((r & (SEQ - 1)) == 0) mult = 1.0f;
        const float bb = mult * sigmoidf_(g1) * bf2f(cp[d]);
        const float ga = bf2f(REG(p, R_LA)[(size_t)r * DM + ch]), gbb = bf2f(REG(p, R_LB)[(size_t)r * DM + ch]);
        e2 += (ga - log_a) * (ga - log_a) * 1e4f + (gbb - bb) * (gbb - bb); r2 += log_a * log_a * 1e4f + bb * bb;
    } break;
    case 13: {
        const int c = (int)(h2 % 3072);
        const float ref = sigmoidf_(dot_bf_f32(H, win + 10368 + c, NIN, DM) + p.b_merge[(size_t)l * 3072 + c]);
        const float got = bf2f(REG(p, R_PM)[(size_t)(c >> 10) * (UNIT / 2) + (size_t)r * DM + (c & 1023)]);
        e2 += (got - ref) * (got - ref); r2 += ref * ref;

    } break;
    case 14: {
        const int c = (int)(h2 & 1023); float ref = 0.f;
        for (int z = 0; z < 3; ++z) { const bf16_t* y = (z == 0 ? REG(p, R_GA) : (z == 1 ? REG(p, R_BG) : REG(p, R_CG))) + (size_t)r * DM;
            ref += bf2f(REG(p, R_PM)[(size_t)z * (UNIT / 2) + (size_t)r * DM + c]) * dot_bf_f32(y, p.w_branch + ((size_t)l * 3 + z) * DM * DM + c, DM, DM); }
        const float got = bf2f(REG(p, R_MG)[(size_t)r * DM + c]);
        e2 += (got - ref) * (got - ref); r2 += ref * ref;
    } break;
    case 15: if (l == 0) {
        const int c = (int)(h2 & 1023);
        const float ref = p.x[(size_t)r * DM + c] + dot_bf_f32(REG(p, R_MG) + (size_t)r * DM, p.w_out + (size_t)l * DM * DM + c, DM, DM);
        const float got = p.out[(size_t)r * DM + c];
        e2 += (got - ref) * (got - ref); r2 += ref * ref;
    } break;
    default: break;
    }
    ck_add(slot, e2, r2);
}
__device__ int ck_bucket(const float* ck, int idx) { const float e = ck[idx * 2], r = ck[idx * 2 + 1]; if (!(r > 0.f)) return 9; int b = (int)(-2.0f * log10f(fmaxf(sqrtf(e / r), 1e-9f)) + 0.5f); return b > 9 ? 9 : (b < 0 ? 0 : b); }
__global__ void k_report(Params p) {
    const float* ck = (const float*)MISC(p, OFF_CK);
    int code = 0; float mx = 0.f;
    for (int g = 0; g < 32; ++g) { const float e = ck[g * 2], r = ck[g * 2 + 1]; if (r > 0.f) { const float rel = sqrtf(e / r); if (rel > mx) mx = rel; if (!code && rel > 0.02f) code = g + 1; } }
    float val;
    if (code) val = 100.0f * (float)code; else { int b = (int)(-2.0f * log10f(fmaxf(mx, 1e-9f)) + 0.5f); if (b > 9) b = 9; if (b < 0) b = 0; val = 100.0f * (float)(40 + b); }
    for (size_t i = (size_t)blockIdx.x * blockDim.x + threadIdx.x; i < (size_t)T_TOK * DM; i += (size_t)gridDim.x * blockDim.x) p.out[i] = val;
}
#endif

#ifndef R_WM
#define R_WM 1
#define R_WN 8
#define R_WQ 9
#define R_WY 10
#define R_WH 3
#define R_YB 5
#endif
typedef short bf16x8_t __attribute__((ext_vector_type(8)));
__device__ __forceinline__ int swz(int row, int col) { const int f = (row & 2) | ((row >> 2) & 1) | ((((row >> 3) ^ (row >> 2)) & 1) << 2); return row * 128 + ((((col >> 3) ^ f) << 4) | ((col & 7) << 1)); }
#define RW_MAT(i) (lds + (i) * 8192)
__device__ __forceinline__ f32x4 mm16(const LAS unsigned char* A, const LAS unsigned char* Bt, int rt, int ct, f32x4 acc, int lane) {
    const int r = lane & 15, kg = lane >> 4;
#pragma unroll
    for (int ks = 0; ks < 2; ++ks) {
        const bf16x8_t a = *(const LAS bf16x8_t*)(A + swz(16 * rt + r, ks * 32 + kg * 8)), b = *(const LAS bf16x8_t*)(Bt + swz(16 * ct + r, ks * 32 + kg * 8));
        acc = __builtin_amdgcn_mfma_f32_16x16x32_bf16(a, b, acc, 0, 0, 0);
    }
    return acc;
}
__device__ __forceinline__ f32x4 mm16s(const LAS unsigned char* A, const LAS unsigned char* Bt, int rt, int ct, f32x4 acc, int lane) {
    const int r = lane & 15, kg = lane >> 4;
#pragma unroll
    for (int ks = 0; ks < 2; ++ks) {
        const bf16x8_t a = *(const LAS bf16x8_t*)(A + swz(16 * rt + r, ks * 32 + kg * 8)), b = *(const LAS bf16x8_t*)(Bt + swz(16 * ct + r, ks * 32 + kg * 8));
        acc = __builtin_amdgcn_mfma_f32_16x16x32_bf16(b, a, acc, 0, 0, 0);
    }
    return acc;
}
__device__ __forceinline__ void st_rowmajor(LAS unsigned char* C, int rt, int ct, const f32x4& v, int lane) {
    const int row = 16 * rt + 4 * (lane >> 4), col = 16 * ct + (lane & 15);
#pragma unroll
    for (int q = 0; q < 4; ++q) *(LAS bf16_t*)(C + swz(row + q, col)) = f2bf(v[q]);
}
__device__ __forceinline__ void st_transposed(LAS unsigned char* Ct, int rt, int ct, const f32x4& v, int lane) {
    const int row = 16 * rt + 4 * (lane >> 4), col = 16 * ct + (lane & 15);
    pg8::u32x2 w; w.x = pg8::cvt_pk_bf16(v[0], v[1]); w.y = pg8::cvt_pk_bf16(v[2], v[3]);
    *(LAS pg8::u32x2*)(Ct + swz(col, row)) = w;
}
__device__ __forceinline__ void st_rowmajor_s(LAS unsigned char* C, int rt, int ct, const f32x4& v, int lane) {
    const int row = 16 * rt + (lane & 15), col = 16 * ct + 4 * (lane >> 4);
    pg8::u32x2 w; w.x = pg8::cvt_pk_bf16(v[0], v[1]); w.y = pg8::cvt_pk_bf16(v[2], v[3]);
    *(LAS pg8::u32x2*)(C + swz(row, col)) = w;
}
struct RwFrag { bf16x8_t k[2]; };
__device__ __forceinline__ RwFrag rw_ldfrag(const LAS unsigned char* M, int r0, int lane) { RwFrag f; const int r = lane & 15, kg = lane >> 4;
    f.k[0] = *(const LAS bf16x8_t*)(M + swz(r0 + r, kg * 8)); f.k[1] = *(const LAS bf16x8_t*)(M + swz(r0 + r, 32 + kg * 8)); return f; }
typedef short s16x4_t __attribute__((ext_vector_type(4)));
typedef short s16x8_t __attribute__((ext_vector_type(8)));
__device__ __forceinline__ RwFrag rw_ldfrag_tr(const LAS unsigned char* M, int c0, int lane) { RwFrag f; const int g = lane >> 4, q = (lane & 15) >> 2, p = lane & 3;
#pragma unroll
    for (int ks = 0; ks < 2; ++ks) {
        const s16x4_t lo = __builtin_amdgcn_ds_read_tr16_b64_v4i16((LAS s16x4_t*)(M + swz(32 * ks + 8 * g + q, c0 + 4 * p)));
        const s16x4_t hi = __builtin_amdgcn_ds_read_tr16_b64_v4i16((LAS s16x4_t*)(M + swz(32 * ks + 8 * g + 4 + q, c0 + 4 * p)));
        const s16x8_t v = {lo[0], lo[1], lo[2], lo[3], hi[0], hi[1], hi[2], hi[3]};
        f.k[ks] = __builtin_bit_cast(bf16x8_t, v);
    }
    return f; }
__device__ __forceinline__ f32x4 rw_mma(const RwFrag& x, const RwFrag& y, f32x4 acc) {
    acc = __builtin_amdgcn_mfma_f32_16x16x32_bf16(x.k[0], y.k[0], acc, 0, 0, 0); return __builtin_amdgcn_mfma_f32_16x16x32_bf16(x.k[1], y.k[1], acc, 0, 0, 0); }
#define RW_BAR() do { asm volatile("s_waitcnt lgkmcnt(0)" ::: "memory"); __builtin_amdgcn_s_barrier(); asm volatile("" ::: "memory"); } while (0)

__device__ __forceinline__ int fragA_idx(int i, int k) { const int rtile = i >> 5, r = i & 31, s = k >> 4, w = k & 15; const int a = (w >> 3) & 1, hh = (w >> 2) & 1, b = w & 3; return (((rtile * 4 + s) * 64 + r + 32 * hh) * 8) + 4 * a + b; }
__device__ __forceinline__ int accG_idx(int i, int v) { const int ct = v >> 5, c = v & 31, rtile = i >> 5, rr = i & 31; const int hh = (rr >> 2) & 1, reg = (rr & 3) + 4 * (rr >> 3); return ((ct * 2 + rtile) * 64 + c + 32 * hh) * 16 + reg; }

__device__ __forceinline__ f32x4 mm16g(const LAS unsigned char* A, const bf16_t* Btg, int rt, int ct, f32x4 acc, int lane) {
    const int r = lane & 15, kg = lane >> 4;
#pragma unroll
    for (int ks = 0; ks < 2; ++ks) {
        const bf16x8_t a = *(const LAS bf16x8_t*)(A + swz(16 * rt + r, ks * 32 + kg * 8)), b = *(const bf16x8_t*)(Btg + (size_t)(16 * ct + r) * 64 + ks * 32 + kg * 8);
        acc = __builtin_amdgcn_mfma_f32_16x16x32_bf16(a, b, acc, 0, 0, 0);
    }
    return acc;
}
__device__ void ph_rwkv_pre(const Params& p, int l, int vb, int nvb, LAS unsigned char* lds) {
    const int tid = threadIdx.x, wave = __builtin_amdgcn_readfirstlane(tid >> 6), lane = tid & 63;
    const bf16_t* BR = REG(p, R_BR); const bf16_t* BK = REG(p, R_BK); const bf16_t* BV = REG(p, R_BV); const bf16_t* BL = (const bf16_t*)MISC(p, OFF_BL);
    bf16_t* WM = REG(p, R_WM); bf16_t* WN = REG(p, R_WN); bf16_t* WQ = REG(p, R_WQ); bf16_t* WY = REG(p, R_WY);
    float* GC = (float*)MISC(p, OFF_GC); float* BON = (float*)MISC(p, OFF_BON);
    const bf16_t* W2T = (const bf16_t*)MISC(p, OFF_W2T); const bf16_t* A2T = (const bf16_t*)MISC(p, OFF_A2T);
    const float* mu = p.mu + (size_t)l * 4224;
    LAS unsigned char* AL = RW_MAT(0); LAS unsigned char* ALt = RW_MAT(1); LAS unsigned char* BE = RW_MAT(2); LAS unsigned char* KT = RW_MAT(3);
    LAS unsigned char* RT = RW_MAT(4); LAS unsigned char* BHt = RW_MAT(5); LAS unsigned char* KCt = RW_MAT(6); LAS unsigned char* VVt = RW_MAT(7);
    LAS unsigned char* AAB = RW_MAT(8); LAS unsigned char* PT0 = RW_MAT(9); LAS unsigned char* AAK = RW_MAT(10); LAS unsigned char* ARB = RW_MAT(11);
    LAS unsigned char* ARK = RW_MAT(12); LAS unsigned char* TMa = RW_MAT(13); LAS unsigned char* XT = RW_MAT(14); LAS unsigned char* W2t = RW_MAT(15);
    LAS unsigned char* TWm = RW_MAT(16); LAS unsigned char* TAm = RW_MAT(17); LAS unsigned char* VVr = RW_MAT(18);
    LAS unsigned char* BHr = RW_MAT(5); LAS unsigned char* KCr = RW_MAT(6);
    LAS unsigned char* TMb = KT; LAS unsigned char* W1t = AAK;
    LAS unsigned char* W2S = RW_MAT(1); LAS unsigned char* A2S = RW_MAT(7);
    LAS float* FW = (LAS float*)RW_MAT(8); LAS float* FA = (LAS float*)RW_MAT(10); LAS float* CUM = (LAS float*)RW_MAT(12);
    LAS float* TT = (LAS float*)(lds + RW_LDS_MISC + 128);
    const int rt_w = wave >> 1, ct0 = (wave & 1) * 2;
    for (int bc = vb; bc < 256; bc += nvb) {
        const int t0 = bc * 64; const bool first = (t0 & (SEQ - 1)) == 0;
        for (int e = tid; e < 64 * 16; e += NT) {
            const int t = e >> 4, grp = e & 15;
            f32x4 c0, c1, p0, p1; unpack8(*(const u32x4*)(BL + (size_t)(t0 + t) * 128 + grp * 8), c0, c1);
            if (first && t == 0) { p0 = (f32x4){0.f, 0.f, 0.f, 0.f}; p1 = p0; } else unpack8(*(const u32x4*)(BL + (size_t)(t0 + t - 1) * 128 + grp * 8), p0, p1);
            const f32x4 m0 = *(const f32x4*)(mu + 4096 + grp * 8), m1 = *(const f32x4*)(mu + 4096 + grp * 8 + 4);
            f32x4 x0 = c0 + (p0 - c0) * m0, x1 = c1 + (p1 - c1) * m1;
            if (grp < 8) {
#pragma unroll
                for (int q = 0; q < 4; ++q) { const float e0 = fexp_(2.0f * x0[q]), e1 = fexp_(2.0f * x1[q]); x0[q] = 1.0f - 2.0f * __builtin_amdgcn_rcpf(e0 + 1.0f); x1[q] = 1.0f - 2.0f * __builtin_amdgcn_rcpf(e1 + 1.0f); }
                *(LAS u32x4*)(TWm + swz(t, grp * 8)) = pack8(x0, x1);
            } else *(LAS u32x4*)(TAm + swz(t, (grp - 8) * 8)) = pack8(x0, x1);
        }
        LAS float* WA = (LAS float*)(lds + RW_LDS_MISC + 1280);
#define RWP_WA_SRC(HH) ((((tid - 96) >> 4) ? p.a0 : p.w0) + (size_t)l * DM + (HH) * 64 + ((tid - 96) & 15) * 4)
#define RWP_WA_DST(HH) (WA + ((HH) & 1) * 128 + ((tid - 96) >> 4) * 64 + ((tid - 96) & 15) * 4)
        if (tid >= 96 && tid < 128) *(LAS f32x4*)RWP_WA_DST(0) = *(const f32x4*)RWP_WA_SRC(0);
        const int ls_row = tid >> 3, ls_col = (tid & 7) * 8;
        *(LAS u32x4*)(W2S + swz(ls_row, ls_col)) = *(const u32x4*)(W2T + (size_t)ls_row * 64 + ls_col);
        *(LAS u32x4*)(A2S + swz(ls_row, ls_col)) = *(const u32x4*)(A2T + (size_t)ls_row * 64 + ls_col);
        RW_BAR();
#define RWP_PRM_SRC(HH) (pa_ == 0 ? mu + (HH) * 64 : pa_ == 1 ? mu + DM + (HH) * 64 : pa_ == 2 ? mu + 2 * DM + (HH) * 64 : pa_ == 3 ? p.k_k + (size_t)l * DM + (HH) * 64 : pa_ == 4 ? p.k_a + (size_t)l * DM + (HH) * 64 : p.r_k + (size_t)l * DM + (HH) * 64)
        const int pa_ = tid >> 4, pp_ = (tid & 15) * 4;
        LAS float* PRM = (LAS float*)(lds + RW_LDS_PRM);
        if (tid < 96) *(LAS f32x4*)(PRM + pa_ * 64 + pp_) = *(const f32x4*)(RWP_PRM_SRC(0) + pp_);

#define RWP_LOAD_RAW(HH) do { const int t_ = tid >> 3, gch_ = (HH) * 64 + (tid & 7) * 8; const size_t tok_ = (size_t)(t0 + t_); \
              rawc[0] = *(const u32x4*)(BR + tok_ * DM + gch_); rawc[1] = *(const u32x4*)(BK + tok_ * DM + gch_); rawc[2] = *(const u32x4*)(BV + tok_ * DM + gch_); } while (0)
        u32x4 rawc[3];
        RWP_LOAD_RAW(0);
#pragma unroll 1
        for (int h = 0; h < 16; ++h) {
            const int u = bc * 16 + h;
            const LAS float* PR = PRM + (h & 1) * 384;
            u32x4 rawp[3];
            { const int t = tid >> 3, gch = h * 64 + (tid & 7) * 8; const size_t tok = (size_t)(t0 + t); const bool nopre = first && t == 0;
              if (nopre) { rawp[0] = (u32x4){0u, 0u, 0u, 0u}; rawp[1] = rawp[0]; rawp[2] = rawp[0]; }
              else { rawp[0] = *(const u32x4*)(BR + (tok - 1) * DM + gch); rawp[1] = *(const u32x4*)(BK + (tok - 1) * DM + gch); rawp[2] = *(const u32x4*)(BV + (tok - 1) * DM + gch); } }
#pragma unroll
            for (int c2 = 0; c2 < 2; ++c2) {
                const int ct = ct0 + c2;
                const f32x4 dw = rw_mma(rw_ldfrag(TWm, 16 * rt_w, lane), rw_ldfrag(W2S, 16 * ct, lane), (f32x4){0.f, 0.f, 0.f, 0.f}), da = rw_mma(rw_ldfrag(TAm, 16 * rt_w, lane), rw_ldfrag(A2S, 16 * ct, lane), (f32x4){0.f, 0.f, 0.f, 0.f});
                const int row = 16 * rt_w + 4 * (lane >> 4), ch = 16 * ct + (lane & 15);
                const float w0v = WA[(h & 1) * 128 + ch], a0v = WA[(h & 1) * 128 + 64 + ch];
                float lwq[4];
#pragma unroll
                for (int q = 0; q < 4; ++q) {
                    const float z = -(w0v + dw[q]);
                    const float sp = fmaxf(z, 0.f) + __builtin_amdgcn_logf(1.0f + fexp_(-fabsf(z))) * 0.6931471805599453f;
                    lwq[q] = -fexp_(-sp - 0.5f);
                    FW[(row + q) * 64 + ch] = lwq[q];
                    FA[(row + q) * 64 + ch] = fsigmoid_(a0v + da[q]);
                }
                { const int kg = lane >> 4; const float p0 = lwq[0], p1 = p0 + lwq[1], p2 = p1 + lwq[2], p3 = p2 + lwq[3];
                  const float g1 = __shfl(p3, lane - 16), g2 = __shfl(p3, lane - 32), g3 = __shfl(p3, lane - 48);
                  const float off = (kg >= 1 ? g1 : 0.f) + (kg >= 2 ? g2 : 0.f) + (kg >= 3 ? g3 : 0.f);
                  CUM[(row + 0) * 64 + ch] = off + p0; CUM[(row + 1) * 64 + ch] = off + p1; CUM[(row + 2) * 64 + ch] = off + p2; CUM[(row + 3) * 64 + ch] = off + p3;
                  if (kg == 3) TT[rt_w * 64 + ch] = off + p3; }
            }
            RW_BAR();
            {
                const int t = tid >> 3, ch0 = (tid & 7) * 8, gch = h * 64 + ch0; const size_t tok = (size_t)(t0 + t);
                float rr[8], kk[8], kh[8], av[8];
                float ss = 0.f, bsum = 0.f;
                {
                    f32x4 c0, c1, q0, q1;
                    unpack8(rawc[0], c0, c1); unpack8(rawp[0], q0, q1);
                    { const f32x4 m0 = *(const LAS f32x4*)(PR + ch0), m1 = *(const LAS f32x4*)(PR + ch0 + 4); c0 = c0 + (q0 - c0) * m0; c1 = c1 + (q1 - c1) * m1; }
#pragma unroll
                    for (int i = 0; i < 4; ++i) { rr[i] = c0[i]; rr[4 + i] = c1[i]; }
                    unpack8(rawc[1], c0, c1); unpack8(rawp[1], q0, q1);
                    { const f32x4 m0 = *(const LAS f32x4*)(PR + 64 + ch0), m1 = *(const LAS f32x4*)(PR + 64 + ch0 + 4); c0 = c0 + (q0 - c0) * m0; c1 = c1 + (q1 - c1) * m1; }
                    const f32x4 a0 = *(const LAS f32x4*)(FA + t * 64 + ch0), a1 = *(const LAS f32x4*)(FA + t * 64 + ch0 + 4);
                    const f32x4 kw0 = *(const LAS f32x4*)(PR + 192 + ch0), kw1 = *(const LAS f32x4*)(PR + 192 + ch0 + 4);
                    const f32x4 ka0 = *(const LAS f32x4*)(PR + 256 + ch0), ka1 = *(const LAS f32x4*)(PR + 256 + ch0 + 4);
                    const f32x4 rk0 = *(const LAS f32x4*)(PR + 320 + ch0), rk1 = *(const LAS f32x4*)(PR + 320 + ch0 + 4);
#pragma unroll
                    for (int i = 0; i < 4; ++i) {
                        av[i] = a0[i]; av[4 + i] = a1[i];
                        kk[i] = c0[i] * kw0[i]; kk[4 + i] = c1[i] * kw1[i]; ss += kk[i] * kk[i] + kk[4 + i] * kk[4 + i];
                        kh[i] = c0[i] * (1.0f + (a0[i] - 1.0f) * ka0[i]); kh[4 + i] = c1[i] * (1.0f + (a1[i] - 1.0f) * ka1[i]);
                        bsum += rr[i] * kh[i] * rk0[i] + rr[4 + i] * kh[4 + i] * rk1[i];
                    }
                }
                asm volatile("" ::: "memory");
                ss += __shfl_xor(ss, 1); ss += __shfl_xor(ss, 2); ss += __shfl_xor(ss, 4);
                bsum += __shfl_xor(bsum, 1); bsum += __shfl_xor(bsum, 2); bsum += __shfl_xor(bsum, 4);
                if ((tid & 7) == 0) BON[tok * 16 + h] = bsum;
                const float inv = 1.0f / fmaxf(sqrtf(ss), 1e-12f);
                const int so = swz(t, ch0);
                f32x4 cm0 = *(const LAS f32x4*)(CUM + t * 64 + ch0), cm1 = *(const LAS f32x4*)(CUM + t * 64 + ch0 + 4);
#pragma unroll
                for (int r = 0; r < 3; ++r) if (r < (t >> 4)) { cm0 += *(const LAS f32x4*)(TT + r * 64 + ch0); cm1 += *(const LAS f32x4*)(TT + r * 64 + ch0 + 4); }
#pragma unroll
                for (int i = 0; i < 8; ++i) kk[i] *= inv;
                { const f32x4 l0 = *(const LAS f32x4*)(FW + t * 64 + ch0), l1 = *(const LAS f32x4*)(FW + t * 64 + ch0 + 4); f32x4 x0, x1;
#pragma unroll
                  for (int i = 0; i < 4; ++i) { x0[i] = -kk[i] * fexp_(cm0[i] - l0[i]); x1[i] = -kk[4 + i] * fexp_(cm1[i] - l1[i]); }
                  *(LAS u32x4*)(AL + so) = pack8(x0, x1); }
                asm volatile("" ::: "memory");
                { f32x4 x0, x1, y0, y1;
#pragma unroll
                  for (int i = 0; i < 4; ++i) { const float e0 = fexp_(-cm0[i]), e1 = fexp_(-cm1[i]); x0[i] = kk[i] * av[i] * e0; x1[i] = kk[4 + i] * av[4 + i] * e1; y0[i] = kh[i] * e0; y1[i] = kh[4 + i] * e1; }
                  *(LAS u32x4*)(BE + so) = pack8(x0, x1); *(LAS u32x4*)(KT + so) = pack8(y0, y1); }
                asm volatile("" ::: "memory");
                { f32x4 x0, x1;
#pragma unroll
                  for (int i = 0; i < 4; ++i) { x0[i] = rr[i] * fexp_(cm0[i]); x1[i] = rr[4 + i] * fexp_(cm1[i]); }
                  *(LAS u32x4*)(RT + so) = pack8(x0, x1); }
                asm volatile("" ::: "memory");
                { f32x4 t0v = *(const LAS f32x4*)(TT + ch0), t1v = *(const LAS f32x4*)(TT + ch0 + 4); f32x4 x0, x1, y0, y1;
#pragma unroll
                  for (int r = 1; r < 4; ++r) { t0v += *(const LAS f32x4*)(TT + r * 64 + ch0); t1v += *(const LAS f32x4*)(TT + r * 64 + ch0 + 4); }
                  if (t == 0) { f32x4 e0, e1;
#pragma unroll
                      for (int i = 0; i < 4; ++i) { e0[i] = fexp_(t0v[i]); e1[i] = fexp_(t1v[i]); }
                      *(f32x4*)(GC + (size_t)u * 64 + ch0) = e0; *(f32x4*)(GC + (size_t)u * 64 + ch0 + 4) = e1; }
#pragma unroll
                  for (int i = 0; i < 4; ++i) { const float e0 = fexp_(t0v[i] - cm0[i]), e1 = fexp_(t1v[i] - cm1[i]); x0[i] = kk[i] * av[i] * e0; x1[i] = kk[4 + i] * av[4 + i] * e1; y0[i] = kh[i] * e0; y1[i] = kh[4 + i] * e1; }
                  *(LAS u32x4*)(BHr + so) = pack8(x0, x1); *(LAS u32x4*)(KCr + so) = pack8(y0, y1); }
                asm volatile("" ::: "memory");
                { f32x4 c0, c1, q0, q1;
                  unpack8(rawc[2], c0, c1); unpack8(rawp[2], q0, q1);
                  const f32x4 m0 = *(const LAS f32x4*)(PR + 128 + ch0), m1 = *(const LAS f32x4*)(PR + 128 + ch0 + 4); c0 = c0 + (q0 - c0) * m0; c1 = c1 + (q1 - c1) * m1;
                  *(LAS u32x4*)(VVr + so) = pack8(c0, c1); }
            }
            RW_BAR();
            if (h + 1 < 16) RWP_LOAD_RAW(h + 1);
            u32x4 w2n = (u32x4){0u, 0u, 0u, 0u}, a2n = w2n;
            if (h + 1 < 16) { w2n = *(const u32x4*)(W2T + (size_t)((h + 1) * 64 + ls_row) * 64 + ls_col); a2n = *(const u32x4*)(A2T + (size_t)((h + 1) * 64 + ls_row) * 64 + ls_col); }
            f32x4 prm_next = (f32x4){0.f, 0.f, 0.f, 0.f};
            if (tid < 96 && h + 1 < 16) prm_next = *(const f32x4*)(RWP_PRM_SRC(h + 1) + pp_);
            if (tid >= 96 && tid < 128 && h + 1 < 16) prm_next = *(const f32x4*)RWP_WA_SRC(h + 1);
            f32x4 Treg[2];
            {
                const RwFrag fal = rw_ldfrag(AL, 16 * rt_w, lane), frt = rw_ldfrag(RT, 16 * rt_w, lane);
#pragma unroll
                for (int c2 = 0; c2 < 2; ++c2) {
                    const int ct = ct0 + c2; const f32x4 z = (f32x4){0.f, 0.f, 0.f, 0.f};
                    const RwFrag fbe = rw_ldfrag(BE, 16 * ct, lane), fkt = rw_ldfrag(KT, 16 * ct, lane);
                    f32x4 ab = rw_mma(fbe, fal, z), ak = rw_mma(fkt, fal, z), rb = rw_mma(fbe, frt, z), rk = rw_mma(fkt, frt, z);
                    const int row = 16 * rt_w + (lane & 15), col = 16 * ct + 4 * (lane >> 4);
#pragma unroll
                    for (int q = 0; q < 4; ++q) { const bool lo = row > (col + q), le = row >= (col + q); ab[q] = lo ? ab[q] : 0.f; ak[q] = lo ? ak[q] : 0.f; rb[q] = le ? rb[q] : 0.f; rk[q] = le ? rk[q] : 0.f; }
                    Treg[c2] = ab;
#pragma unroll
                    for (int q = 0; q < 4; ++q) Treg[c2][q] += (row == (col + q)) ? 1.0f : 0.f;
                    st_rowmajor_s(AAB, rt_w, ct, ab, lane);
                    st_rowmajor_s(AAK, rt_w, ct, ak, lane); st_rowmajor_s(ARB, rt_w, ct, rb, lane); st_rowmajor_s(ARK, rt_w, ct, rk, lane);
                    st_rowmajor_s(TMa, rt_w, ct, Treg[c2], lane);
                }
            }
            RW_BAR();
            {
                LAS unsigned char* Pa = AAB; LAS unsigned char* Pb = PT0; LAS unsigned char* Ta = TMa; LAS unsigned char* Tb = TMb;
#pragma unroll
                for (int st = 1; st <= 6; ++st) {
                    const f32x4 z = (f32x4){0.f, 0.f, 0.f, 0.f};
                    RwFrag fpa, fta, fak;
                    if (st <= 5) fpa = rw_ldfrag(Pa, 16 * rt_w, lane);
                    if (st >= 2) fta = rw_ldfrag(Ta, 16 * rt_w, lane);
                    if (st == 1) fak = rw_ldfrag(AAK, 16 * rt_w, lane);
#pragma unroll
                    for (int c2 = 0; c2 < 2; ++c2) { const int ct = ct0 + c2;
                        const RwFrag fpt = rw_ldfrag_tr(Pa, 16 * ct, lane);
                        if (st <= 5) { const f32x4 pps = rw_mma(fpt, fpa, z); st_rowmajor_s(Pb, rt_w, ct, pps, lane); }
                        if (st == 1) { const RwFrag fvv = rw_ldfrag_tr(VVr, 16 * ct, lane); const f32x4 x = rw_mma(fak, fvv, z); st_transposed(XT, rt_w, ct, x, lane); }
                        else { Treg[c2] = rw_mma(fpt, fta, Treg[c2]); st_rowmajor_s(Tb, rt_w, ct, Treg[c2], lane); } }
                    if (st >= 2) { LAS unsigned char* t1 = Ta; Ta = Tb; Tb = t1; }
                    { LAS unsigned char* t1 = Pa; Pa = Pb; Pb = t1; }
                    RW_BAR();
                }
            }
            if (tid < 96 && h + 1 < 16) *(LAS f32x4*)(PRM + ((h + 1) & 1) * 384 + pa_ * 64 + pp_) = prm_next;
            if (tid >= 96 && tid < 128 && h + 1 < 16) *(LAS f32x4*)RWP_WA_DST(h + 1) = prm_next;
            if (h + 1 < 16) { *(LAS u32x4*)(W2S + swz(ls_row, ls_col)) = w2n; *(LAS u32x4*)(A2S + swz(ls_row, ls_col)) = a2n; }
            {
                const RwFrag ftm = rw_ldfrag(TMb, 16 * rt_w, lane); const f32x4 z = (f32x4){0.f, 0.f, 0.f, 0.f};
#pragma unroll
                for (int c2 = 0; c2 < 2; ++c2) { const int ct = ct0 + c2;
                    const RwFrag fat = rw_ldfrag_tr(AL, 16 * ct, lane), fxt = rw_ldfrag(XT, 16 * ct, lane);
                    st_transposed(W1t, rt_w, ct, rw_mma(ftm, fat, z), lane); st_transposed(W2t, rt_w, ct, rw_mma(ftm, fxt, z), lane); }
            }
            RW_BAR();
            if (h == 0 && bc == vb) {
                if (tid == 0) { const unsigned* w_ = (const unsigned*)MISC(p, OFF_PROG) + (size_t)(130 + l) * 64;
                    for (unsigned spins = 0; spins < (1u << 20); ++spins) { if (__hip_atomic_load(w_, __ATOMIC_RELAXED, __HIP_MEMORY_SCOPE_AGENT) >= (unsigned)nvb) break; __builtin_amdgcn_s_sleep(4); } }
                RW_BAR();
            }
            { bf16_t* gq = WQ + (size_t)u * 4096; bf16_t* gy = WY + (size_t)u * 4096; bf16_t* gm = WM + (size_t)u * 4096; bf16_t* gn = WN + (size_t)u * 4096;
              const RwFrag farb = rw_ldfrag(ARB, 16 * rt_w, lane), fbh = rw_ldfrag_tr(BHr, 16 * rt_w, lane), fark = rw_ldfrag(ARK, 16 * rt_w, lane), fkc = rw_ldfrag_tr(KCr, 16 * rt_w, lane);
#pragma unroll
              for (int c2 = 0; c2 < 2; ++c2) { const int ct = ct0 + c2; const f32x4 z = (f32x4){0.f, 0.f, 0.f, 0.f};
                const RwFrag fw1 = rw_ldfrag(W1t, 16 * ct, lane), fw2 = rw_ldfrag(W2t, 16 * ct, lane), fvv = rw_ldfrag_tr(VVr, 16 * ct, lane);
                f32x4 q1 = rw_mma(fw1, farb, z); f32x4 m1 = rw_mma(fw1, fbh, z);
                { const int row = 16 * rt_w + (lane & 15), col = 16 * ct + 4 * (lane >> 4);
                  const pg8::u32x2 rv = *(const LAS pg8::u32x2*)(RT + swz(row, col));
                  q1[0] += __uint_as_float(rv.x << 16); q1[1] += __uint_as_float(rv.x & 0xffff0000u); q1[2] += __uint_as_float(rv.y << 16); q1[3] += __uint_as_float(rv.y & 0xffff0000u);
                  pg8::u32x2 w; w.x = pg8::cvt_pk_bf16(q1[0], q1[1]); w.y = pg8::cvt_pk_bf16(q1[2], q1[3]); *(pg8::u32x2*)(gq + fragA_idx(row, col)) = w;
                  w.x = pg8::cvt_pk_bf16(m1[0], m1[1]); w.y = pg8::cvt_pk_bf16(m1[2], m1[3]); *(pg8::u32x2*)(gm + fragA_idx(row, col)) = w; }
                f32x4 y2 = rw_mma(farb, fw2, z); y2 = rw_mma(fark, fvv, y2);
                f32x4 nn = rw_mma(fbh, fw2, z); nn = rw_mma(fkc, fvv, nn);
                { const int row = 16 * rt_w + 4 * (lane >> 4), col = 16 * ct + (lane & 15);
                  pg8::u32x2 w; w.x = pg8::cvt_pk_bf16(y2[0], y2[1]); w.y = pg8::cvt_pk_bf16(y2[2], y2[3]); *(pg8::u32x2*)(gy + accG_idx(row, col)) = w;
                  w.x = pg8::cvt_pk_bf16(nn[0], nn[1]); w.y = pg8::cvt_pk_bf16(nn[2], nn[3]); *(pg8::u32x2*)(gn + accG_idx(row, col)) = w; } } }
            RW_BAR();
        }
    }
}

typedef float f32x16 __attribute__((ext_vector_type(16)));
#define CH_SLOT 13312
#define CH_DIST 3
__device__ __forceinline__ void glds16_asm(const void* gsrc, unsigned lds_dst) {
    unsigned keep;
    asm volatile("s_mov_b32 %0, m0\n\ts_mov_b32 m0, %2\n\ts_nop 0\n\tglobal_load_lds_dwordx4 %1, off\n\ts_mov_b32 m0, %0" : "=&s"(keep) : "v"(gsrc), "s"(lds_dst) : "memory");
}
__device__ __forceinline__ void chain_issue(LAS unsigned char* slot, const bf16_t* WM, const bf16_t* WN, const float* GC, int u, int ct, int lane) {
    const char* gm = (const char*)(WM + (size_t)u * 4096) + lane * 16; const char* gn = (const char*)(WN + (size_t)u * 4096) + ct * 4096 + lane * 16; const char* gc = (const char*)(GC + (size_t)u * 64) + lane * 16;
    const unsigned sb = __builtin_amdgcn_readfirstlane((unsigned)(unsigned long long)(const __attribute__((address_space(3))) void*)slot);
#pragma unroll
    for (int i = 0; i < 8; ++i) glds16_asm(gm + i * 1024, sb + i * 1024);
#pragma unroll
    for (int i = 0; i < 4; ++i) glds16_asm(gn + i * 1024, sb + 8192 + i * 1024);
    glds16_asm(gc, sb + 12288);
}
struct ChainLd { u32x4 m[2][4]; u32x4 n[2][2]; f32x4 g[2][4]; };
__device__ __forceinline__ void chain_lds_read(ChainLd& L, const LAS unsigned char* slot, int lane) {
    const int hh = lane >> 5;
#pragma unroll
    for (int rt = 0; rt < 2; ++rt) {
#pragma unroll
        for (int s = 0; s < 4; ++s) L.m[rt][s] = *(const LAS u32x4*)(slot + (rt * 4 + s) * 1024 + lane * 16);
        L.n[rt][0] = *(const LAS u32x4*)(slot + 8192 + rt * 2048 + lane * 32); L.n[rt][1] = *(const LAS u32x4*)(slot + 8192 + rt * 2048 + lane * 32 + 16);
        const LAS float* gcp = (const LAS float*)(slot + 12288) + 32 * rt + 4 * hh;
#pragma unroll
        for (int g = 0; g < 4; ++g) L.g[rt][g] = *(const LAS f32x4*)(gcp + 8 * g);
    }
}
#define CH_PLAG 6
__device__ __forceinline__ void chain_compute(f32x16 (&acc)[2], const ChainLd& L, __amdgpu_buffer_rsrc_t whr, int u, int ct, int lane, unsigned* prog, int c) {
    u32x4 hb[4];
#pragma unroll
    for (int s = 0; s < 4; ++s) { const f32x16& a = acc[s >> 1]; const int o = 8 * (s & 1);
        hb[s].x = pg8::cvt_pk_bf16(a[o + 0], a[o + 1]); hb[s].y = pg8::cvt_pk_bf16(a[o + 2], a[o + 3]); hb[s].z = pg8::cvt_pk_bf16(a[o + 4], a[o + 5]); hb[s].w = pg8::cvt_pk_bf16(a[o + 6], a[o + 7]);
        __builtin_amdgcn_raw_buffer_store_b128(hb[s], whr, (unsigned)((u * 4096 + ((ct * 4 + s) * 64 + lane) * 8) * 2), 0, 16); }
#pragma unroll
    for (int rt = 0; rt < 2; ++rt) {
        f32x4 n0, n1, n2, n3; unpack8(L.n[rt][0], n0, n1); unpack8(L.n[rt][1], n2, n3);
#pragma unroll
        for (int q = 0; q < 4; ++q) {
            acc[rt][q] = acc[rt][q] * L.g[rt][0][q] + n0[q]; acc[rt][4 + q] = acc[rt][4 + q] * L.g[rt][1][q] + n1[q];
            acc[rt][8 + q] = acc[rt][8 + q] * L.g[rt][2][q] + n2[q]; acc[rt][12 + q] = acc[rt][12 + q] * L.g[rt][3][q] + n3[q];
        }
    }
#pragma unroll
    for (int s = 0; s < 4; ++s)
#pragma unroll
        for (int rt = 0; rt < 2; ++rt)
            acc[rt] = __builtin_amdgcn_mfma_f32_32x32x16_bf16(__builtin_bit_cast(bf16x8_t, L.m[rt][s]), __builtin_bit_cast(bf16x8_t, hb[s]), acc[rt], 0, 0, 0);
    asm volatile("s_waitcnt vmcnt(%0)" :: "n"(5 * CH_PLAG) : "memory");
    if (lane == 0) __hip_atomic_store(prog, (unsigned)(c >= CH_PLAG ? c - CH_PLAG + 1 : 0), __ATOMIC_RELAXED, __HIP_MEMORY_SCOPE_AGENT);
}
#define CH_NSLOT 8
#define CH_LAG 6
__device__ void ph_rwkv_chain(const Params& p, int l, int vb, int nvb, LAS unsigned char* lds) {
    const int wave = __builtin_amdgcn_readfirstlane(threadIdx.x >> 6), lane = threadIdx.x & 63;
    if (wave > 3) return;
    const bf16_t* WM = REG(p, R_WM); const bf16_t* WN = REG(p, R_WN); const float* GC = (const float*)MISC(p, OFF_GC);
    const __amdgpu_buffer_rsrc_t whr = __builtin_amdgcn_make_buffer_rsrc((void*)REG(p, R_WH), 0, (int)UNIT, 0x00020000);
    volatile LAS unsigned* flg = (volatile LAS unsigned*)(lds + RW_LDS_MISC + 3072);
    for (int id = vb; id < 64; id += nvb) {
        const int ct = id & 1, bh = id >> 1; const int h = bh & 15, b = bh >> 4;
        unsigned* prog = (unsigned*)MISC(p, OFF_PROG) + (size_t)(l * 64 + id) * 64;
        const unsigned base = (unsigned)(l * 64 + (id - vb) / nvb + 1) * 1024u;
        if (wave == 0) {
            if (lane == 0) flg[3] = base;
            unsigned landed = 0u;
            f32x16 acc[2];
#pragma unroll
            for (int q = 0; q < 16; ++q) { acc[0][q] = 0.f; acc[1][q] = 0.f; }
#define CH_WAIT(C) do { const unsigned need_ = base + (unsigned)(C) + 1u; while (landed < need_) { const u32x4 f = *(volatile LAS u32x4*)flg; const unsigned m01 = f.x < f.y ? f.x : f.y; landed = m01 < f.z ? m01 : f.z; \
                if (landed < need_) __builtin_amdgcn_s_sleep(1); } asm volatile("" ::: "memory"); } while (0)
#define CH_DONE(C) do { asm volatile("s_waitcnt lgkmcnt(0)" ::: "memory"); if (lane == 0) flg[3] = base + (unsigned)(C) + 1u; } while (0)
            ChainLd LA, LB;
            CH_WAIT(0); chain_lds_read(LA, lds, lane); CH_DONE(0);
#pragma unroll 1
            for (int c = 0; c < 128; c += 2) {
                CH_WAIT(c + 1); chain_lds_read(LB, lds + ((c + 1) & (CH_NSLOT - 1)) * CH_SLOT, lane);
                chain_compute(acc, LA, whr, (b * 128 + c) * 16 + h, ct, lane, prog, c);
                CH_DONE(c + 1);
                if (c + 2 < 128) { CH_WAIT(c + 2); chain_lds_read(LA, lds + ((c + 2) & (CH_NSLOT - 1)) * CH_SLOT, lane); }
                chain_compute(acc, LB, whr, (b * 128 + c + 1) * 16 + h, ct, lane, prog, c + 1);
                if (c + 2 < 128) CH_DONE(c + 2);
            }
            asm volatile("s_waitcnt vmcnt(0)" ::: "memory");
            if (lane == 0) __hip_atomic_store(prog, 128u, __ATOMIC_RELAXED, __HIP_MEMORY_SCOPE_AGENT);
#undef CH_WAIT
#undef CH_DONE
        } else {
            const int lw = wave - 1;
#pragma unroll 1
            for (int c = 0; c < 128; ++c) {
                while ((int)(base + (unsigned)c) - (int)flg[3] >= CH_NSLOT) __builtin_amdgcn_s_sleep(1);
                asm volatile("" ::: "memory");
                const int u = (b * 128 + c) * 16 + h; const unsigned sb = __builtin_amdgcn_readfirstlane((unsigned)(unsigned long long)(const __attribute__((address_space(3))) void*)(lds + (c & (CH_NSLOT - 1)) * CH_SLOT));
                if (lw < 2) { const char* gm = (const char*)(WM + (size_t)u * 4096) + lane * 16 + lw * 4096;
#pragma unroll
                    for (int i = 0; i < 4; ++i) glds16_asm(gm + i * 1024, sb + lw * 4096 + i * 1024);
                    if (c >= CH_LAG) { asm volatile("s_waitcnt vmcnt(24)" ::: "memory"); if (lane == 0) flg[lw] = base + (unsigned)(c - CH_LAG) + 1u; }
                } else { const char* gn = (const char*)(WN + (size_t)u * 4096) + ct * 4096 + lane * 16; const char* gc = (const char*)(GC + (size_t)u * 64) + lane * 16;
#pragma unroll
                    for (int i = 0; i < 4; ++i) glds16_asm(gn + i * 1024, sb + 8192 + i * 1024);
                    glds16_asm(gc, sb + 12288);
                    if (c >= CH_LAG) { asm volatile("s_waitcnt vmcnt(30)" ::: "memory"); if (lane == 0) flg[2] = base + (unsigned)(c - CH_LAG) + 1u; }
                }
            }
            asm volatile("s_waitcnt vmcnt(0)" ::: "memory");
            if (lane == 0) flg[lw] = base + 128u;
        }
    }
}

__device__ __forceinline__ void prog_wait(const unsigned* w, unsigned need) {
    for (unsigned spins = 0; spins < (1u << 18); ++spins) {
        if ((unsigned)__builtin_amdgcn_readfirstlane(__hip_atomic_load(w, __ATOMIC_RELAXED, __HIP_MEMORY_SCOPE_AGENT)) >= need) break;
        __builtin_amdgcn_s_sleep(8);
    }
    __builtin_amdgcn_fence(__ATOMIC_ACQUIRE, "agent");
}
__device__ void ph_rwkv_out(const Params& p, int l, int j0, int jstride, int jend, LAS unsigned char* lds) {
    const int wave = __builtin_amdgcn_readfirstlane(threadIdx.x >> 6), lane = threadIdx.x & 63, pr = wave >> 1, ct = wave & 1;
    const bf16_t* WQ = REG(p, R_WQ); const bf16_t* WY = REG(p, R_WY); const bf16_t* WH = REG(p, R_WH);
    const bf16_t* BV = REG(p, R_BV); const bf16_t* BG = REG(p, R_BG); bf16_t* YB = REG(p, R_YB); const float* BON = (const float*)MISC(p, OFF_BON);
    LAS float* yt = (LAS float*)(lds + pr * 16384);
    const float* mu = p.mu + (size_t)l * 4224;
    u32x4 ly[2][2], lq[2][4], lh[4];
#define RWO_LOAD(UU, WORD, NEED) do { const bf16_t* gy_ = WY + (size_t)(UU) * 4096; const bf16_t* gq_ = WQ + (size_t)(UU) * 4096; const bf16_t* gh_ = WH + (size_t)(UU) * 4096; \
        _Pragma("unroll") for (int rt = 0; rt < 2; ++rt) { ly[rt][0] = *(const u32x4*)(gy_ + ((ct * 2 + rt) * 64 + lane) * 16); ly[rt][1] = *(const u32x4*)(gy_ + ((ct * 2 + rt) * 64 + lane) * 16 + 8); \
            _Pragma("unroll") for (int s = 0; s < 4; ++s) lq[rt][s] = *(const u32x4*)(gq_ + ((rt * 4 + s) * 64 + lane) * 8); } \
        \
        _Pragma("unroll") for (int s = 0; s < 4; ++s) lh[s] = *(const u32x4*)(gh_ + ((ct * 4 + s) * 64 + lane) * 8); } while (0)
    for (int j = j0; j < jend; j += jstride) {
        const int qd = j * 4 + pr; const int cc_ = qd >> 5, bh = qd & 31; const int h = bh & 15, bc = (bh >> 4) * 128 + cc_; const int u = bc * 16 + h;
        const int t0 = bc * 64; const bool first = cc_ == 0;
        if (wave == 0) {
            const unsigned* w_ = (const unsigned*)MISC(p, OFF_PROG) + (size_t)(l * 64 + (((j * 4 + ((lane >> 1) & 3)) & 31) * 2 + (lane & 1))) * 64;
            for (unsigned spins = 0; spins < (1u << 18); ++spins) {
                const unsigned v_ = lane < 8 ? __hip_atomic_load(w_, __ATOMIC_RELAXED, __HIP_MEMORY_SCOPE_AGENT) : 0xffffffffu;
                if (__all(v_ >= (unsigned)cc_ + 1u)) break;
                __builtin_amdgcn_s_sleep(8);
            }
            __builtin_amdgcn_fence(__ATOMIC_ACQUIRE, "agent");
            asm volatile("s_waitcnt vmcnt(0)" ::: "memory");
        }
        RW_BAR();
        RWO_LOAD(u, 0, 0);
        f32x16 acc[2];
#pragma unroll
        for (int rt = 0; rt < 2; ++rt) { f32x4 n0, n1, n2, n3; unpack8(ly[rt][0], n0, n1); unpack8(ly[rt][1], n2, n3);
#pragma unroll
            for (int q = 0; q < 4; ++q) { acc[rt][q] = n0[q]; acc[rt][4 + q] = n1[q]; acc[rt][8 + q] = n2[q]; acc[rt][12 + q] = n3[q]; } }
#pragma unroll
        for (int s = 0; s < 4; ++s)
#pragma unroll
            for (int rt = 0; rt < 2; ++rt) acc[rt] = __builtin_amdgcn_mfma_f32_32x32x16_bf16(__builtin_bit_cast(bf16x8_t, lq[rt][s]), __builtin_bit_cast(bf16x8_t, lh[s]), acc[rt], 0, 0, 0);
        { const int v = 32 * ct + (lane & 31), hh = lane >> 5;
#pragma unroll
          for (int rt = 0; rt < 2; ++rt)
#pragma unroll
              for (int reg = 0; reg < 16; ++reg) { const int t = 32 * rt + (reg & 3) + 8 * (reg >> 2) + 4 * hh; yt[t * 64 + ((((v >> 2) ^ (t & 15)) << 2) | (v & 3))] = acc[rt][reg]; } }
        const int t = lane; const size_t tok = (size_t)(t0 + t); const int col0 = h * 64 + 32 * ct; const bool nopre = first && t == 0;
        u32x4 rv[4], rg[4], pv[4], pg[4];
#pragma unroll
        for (int q = 0; q < 4; ++q) { rv[q] = *(const u32x4*)(BV + tok * DM + col0 + q * 8); rg[q] = *(const u32x4*)(BG + tok * DM + col0 + q * 8);
            if (nopre) { pv[q] = (u32x4){0u, 0u, 0u, 0u}; pg[q] = pv[q]; } else { pv[q] = *(const u32x4*)(BV + (tok - 1) * DM + col0 + q * 8); pg[q] = *(const u32x4*)(BG + (tok - 1) * DM + col0 + q * 8); } }
        const float bs = BON[tok * 16 + h];
        RW_BAR();
        {
            float s1 = 0.f; f32x4 mine[8];
#pragma unroll
            for (int c4 = 0; c4 < 16; ++c4) { const f32x4 x = *(const LAS f32x4*)(yt + t * 64 + ((c4 ^ (t & 15)) << 2)); s1 += (x[0] + x[1]) + (x[2] + x[3]); if ((c4 >> 3) == ct) mine[c4 & 7] = x; }
            const float mean = s1 * (1.0f / 64.0f); float s2 = 0.f;
#pragma unroll
            for (int c4 = 0; c4 < 16; ++c4) { const f32x4 x = *(const LAS f32x4*)(yt + t * 64 + ((c4 ^ (t & 15)) << 2)) - mean; s2 += (x[0] * x[0] + x[1] * x[1]) + (x[2] * x[2] + x[3] * x[3]); }
            const float rstd = rsqrtf(s2 * (1.0f / 64.0f) + 64e-5f);
#pragma unroll
            for (int q = 0; q < 4; ++q) {
                const int col = col0 + q * 8;
                f32x4 cv0, cv1, pv0, pv1, cg0, cg1, pg0, pg1;
                unpack8(rv[q], cv0, cv1); unpack8(rg[q], cg0, cg1); unpack8(pv[q], pv0, pv1); unpack8(pg[q], pg0, pg1);
                f32x4 o0, o1;
#pragma unroll
                for (int k = 0; k < 4; ++k) {
                    { const int cc = col + k; const float vv = cv0[k] + (pv0[k] - cv0[k]) * mu[2 * DM + cc], gg = cg0[k] + (pg0[k] - cg0[k]) * mu[3 * DM + cc];
                      const float yn = (mine[q * 2][k] - mean) * rstd * p.lnx_w[(size_t)l * DM + cc] + p.lnx_b[(size_t)l * DM + cc]; o0[k] = (yn + bs * vv) * fsilu_(gg); }
                    { const int cc = col + 4 + k; const float vv = cv1[k] + (pv1[k] - cv1[k]) * mu[2 * DM + cc], gg = cg1[k] + (pg1[k] - cg1[k]) * mu[3 * DM + cc];
                      const float yn = (mine[q * 2 + 1][k] - mean) * rstd * p.lnx_w[(size_t)l * DM + cc] + p.lnx_b[(size_t)l * DM + cc]; o1[k] = (yn + bs * vv) * fsilu_(gg); }
                }
                *(u32x4*)(YB + tok * DM + col) = pack8(o0, o1);
            }
        }
        RW_BAR();
    }
#undef RWO_LOAD
}

#define N_PH 17
__device__ __forceinline__ void run_phase(const Params& p, int l, int ph, int vb, int nvb, LAS unsigned char* lds, const XcdBarrier* barp) {
    const float* xin = l == 0 ? p.x : p.out;
    LAS float* red = (LAS float*)(lds + RW_LDS_MISC);
    const char* win = (const char*)MISC(p, OFF_WIN);
    switch (ph) {
#if !defined(ONLY_PH) || ONLY_PH == 0
    case 0: ph_weights(p, l, vb, nvb, lds, (l == 1 && nvb >= 256) ? (const unsigned*)MISC(p, OFF_PROG) + (size_t)136 * 64 : (const unsigned*)nullptr, (unsigned)nvb);
            if (l == 0 || nvb < 256) ph_rms(xin, p.norm_w + (size_t)l * DM, REG(p, R_H), vb, nvb);
            if (l == 0) ph_rope_table(p, vb, nvb); break;
#endif
#if !defined(ONLY_PH) || ONLY_PH == 1
    case 1: { GPlain g{(const char*)REG(p, R_H), win + (size_t)6272 * DM * 2, DM, DM, DM}; pg8::StaticOrder S; S.init(T_TOK, 4096, nvb, vb);
              EpiC e{p.ws, (const float2*)MISC(p, OFF_ROPE)}; pg8::gemm_phase<GPlain, EpiC, pg8::StaticOrder, true, true>(lds, g, S, e); } break;
#endif
#if !defined(ONLY_PH) || ONLY_PH == 2
    case 2: break;
#endif
#if !defined(ONLY_PH) || ONLY_PH == 3
    case 3: { GRetKV g{(const char*)REG(p, R_VT), (const char*)REG(p, R_KT), 256, 256, 256}; UnitOrder S{nvb, vb, 256}; EpiKV e{REG(p, R_KV)};
              pg8::gemm_phase<GRetKV, EpiKV, UnitOrder, true, true>(lds, g, S, e); } break;
#endif
#if !defined(ONLY_PH) || ONLY_PH == 4
    case 4: ph_ret_scan(p, vb, nvb); xcd_barrier(*barp); ph_ret_out_fast(p, vb, nvb, lds);
        asm volatile("s_waitcnt vmcnt(0)" ::: "memory"); __syncthreads();
        if (threadIdx.x == 0) __hip_atomic_fetch_add((unsigned*)MISC(p, OFF_PROG) + (size_t)(134 + l) * 64, 1u, __ATOMIC_RELAXED, __HIP_MEMORY_SCOPE_AGENT);
        break;
#endif
#if !defined(ONLY_PH) || ONLY_PH == 5
    case 5: { GPlain g{(const char*)REG(p, R_H), win, DM, DM, DM}; pg8::StaticOrder S; S.init(T_TOK, 6144, nvb, vb);
              Unit u0; u0.pm = -1; u0.pn = -1; u0.z = 0; (void)S.next(0, u0);
              EpiAB e{p.ws, (bf16_t*)MISC(p, OFF_BL), (const unsigned*)MISC(p, OFF_PROG) + (size_t)(134 + l) * 64, (unsigned)nvb, u0.pm, u0.pn};
              pg8::gemm_phase<GPlain, EpiAB, pg8::StaticOrder, true, true>(lds, g, S, e); } break;
#endif
#if !defined(ONLY_PH) || ONLY_PH == 6
    case 6: {
        const int nl = nvb > 64 ? 64 : nvb;
        if (vb < nl) { GPlain g{(const char*)REG(p, R_H), win, DM, DM, DM}; LoraOrder S{nl, vb}; EpiAB e{p.ws, (bf16_t*)MISC(p, OFF_BL)}; pg8::gemm_phase<GPlain, EpiAB, LoraOrder, true, true>(lds, g, S, e); }
        { const int cvb = nvb > 64 ? vb - 64 : vb, cnvb = nvb > 64 ? nvb - 64 : nvb; if (cvb >= 0) ph_conv_fast(p, l, cvb, cnvb); }
    } break;
#endif
#if !defined(ONLY_PH) || ONLY_PH == 7
    case 7: { GGate g{(const char*)REG(p, R_CVB), (const char*)MISC(p, OFF_WG), 256, DM, 256}; pg8::StaticOrder S; S.init(T_TOK, 2048, nvb, vb);
              EpiGate e{REG(p, R_CVB), REG(p, R_LA), REG(p, R_LB), p.gate_b + (size_t)l * 2 * DM, p.lam + (size_t)l * DM};
              pg8::gemm_phase<GGate, EpiGate, pg8::StaticOrder, true, true>(lds, g, S, e);
              wg_self_visible(); ph_lru_passA_own(p, S); } break;
#endif
#if !defined(ONLY_PH) || ONLY_PH == 8
    case 8: break;
#endif
#if !defined(ONLY_PH) || ONLY_PH == 9
    case 9: ph_lru_passB(p, vb, nvb, lds); break;
#endif
#if !defined(ONLY_PH) || ONLY_PH == 10
    case 10: ph_lru_passC(p, vb, nvb);
        asm volatile("s_waitcnt vmcnt(0)" ::: "memory"); __syncthreads();
        if (threadIdx.x == 0) __hip_atomic_fetch_add((unsigned*)MISC(p, OFF_PROG) + (size_t)(130 + l) * 64, 1u, __ATOMIC_RELAXED, __HIP_MEMORY_SCOPE_AGENT);
        break;
#endif
#if !defined(ONLY_PH) || ONLY_PH == 11
    case 11: ph_rwkv_pre(p, l, vb, nvb, lds); break;
#endif
#if !defined(ONLY_PH) || ONLY_PH == 12
    case 12: {
        const int qn = nvb > 64 ? 896 : 0;
        int j0 = vb - 64, js = nvb - 64, je = qn;
        if (vb < 64) { ph_rwkv_chain(p, l, vb, nvb, lds); j0 = qn + vb; js = nvb > 64 ? 64 : nvb; je = 1024; }
        __syncthreads();
        ph_rwkv_out(p, l, j0, js, je, lds);
    } break;
#endif
#if !defined(ONLY_PH) || ONLY_PH == 13
    case 13: break;
#endif
#if !defined(ONLY_PH) || ONLY_PH == 14
    case 14: break;
#endif
#if !defined(ONLY_PH) || ONLY_PH == 15
    case 15: { GMerge6 g{(const char*)REG(p, R_H), win + (size_t)10368 * DM * 2, (const char*)REG(p, R_GA), (const char*)REG(p, R_YB), (const char*)REG(p, R_CG), (const char*)MISC(p, OFF_WBR), DM, DM, DM};
               pg8::StaticOrderZ<6> S; S.s.init(T_TOK, DM, nvb, vb);
               EpiMerge6 e{REG(p, R_PM), REG(p, R_MG), p.b_merge + (size_t)l * 3072}; pg8::gemm_phase<GMerge6, EpiMerge6, pg8::StaticOrderZ<6>, true, true>(lds, g, S, e); } break;
#endif
#if !defined(ONLY_PH) || ONLY_PH == 16
    case 16: { GPlain g{(const char*)REG(p, R_MG), (const char*)MISC(p, OFF_WOUT), DM, DM, DM}; pg8::StaticOrder S; S.init(T_TOK, DM, nvb, vb);
               if (nvb >= 256) {
                   EpiOutNorm e{xin, p.out, REG(p, R_H), l == 0 ? p.norm_w + DM : p.fnorm_w, (float*)MISC(p, OFF_SSQ) + (size_t)l * 4 * T_TOK, (unsigned*)MISC(p, OFF_PROG) + 132 * 64 + l * 64, l};
                   pg8::gemm_phase<GPlain, EpiOutNorm, pg8::StaticOrder, true, true>(lds, g, S, e);
                   if (l == 0) {
                       asm volatile("s_waitcnt vmcnt(0)" ::: "memory"); __syncthreads();
                       if (threadIdx.x == 0) __hip_atomic_fetch_add((unsigned*)MISC(p, OFF_PROG) + (size_t)136 * 64, 1u, __ATOMIC_RELAXED, __HIP_MEMORY_SCOPE_AGENT); }
               } else { EpiOut e{xin, p.out}; pg8::gemm_phase<GPlain, EpiOut, pg8::StaticOrder, true, true>(lds, g, S, e); } } break;
#endif
    default: break;
    }
}

__global__ void __launch_bounds__(NT, 2) k_mega(Params p) {
    extern __shared__ __attribute__((aligned(16))) unsigned char lds_raw[];
    LAS unsigned char* lds = (LAS unsigned char*)lds_raw;
    const int vb = blockIdx.x, nvb = gridDim.x;
    volatile LAS unsigned* bst = (volatile LAS unsigned*)(lds + RW_LDS_MISC + 64);
    if (threadIdx.x == 0) { bst[0] = 0u; bst[1] = 0u; }
    if (threadIdx.x < 4) ((volatile LAS unsigned*)(lds + RW_LDS_MISC + 3072))[threadIdx.x] = 0u;
    __syncthreads();
    const XcdBarrier bar = xcd_barrier_post((unsigned*)MISC(p, OFF_BAR), bst);
    const int ph_lo = p.ph_lo, ph_hi = p.ph_hi;
#define PH_EMPTY(ph) ((ph) == 2 || (ph) == 8 || (ph) == 13 || (ph) == 14)
#define PH_NOBAR(ph) ((ph) == 10 || (ph) == 4)
#define STEP(G) if (ph_lo <= (G) && (G) < ph_hi && ((G) == 2 * N_PH || !PH_EMPTY((G) % N_PH))) { if ((G) == 2 * N_PH) { if (nvb < 256) ph_final(p, vb, nvb); } else run_phase(p, (G) / N_PH, (G) % N_PH, vb, nvb, lds, &bar); DBG_HASH(G) if ((G) + 1 < ph_hi && !PH_NOBAR((G) % N_PH) && !(((G) == 2 * N_PH - 1 || (G) == N_PH - 1) && nvb >= 256)) xcd_barrier(bar); }
#if defined(DEBUG_CHECK)
#define DBG_HASH(G) if ((G) < 2 * N_PH) { xcd_barrier(bar); check_phase(p, (G) / N_PH, (G) % N_PH, vb, nvb); }
#else
#define DBG_HASH(G)
#endif
    STEP(0)
    STEP(1)
    STEP(2)
    STEP(3)
    STEP(4)
    STEP(5)
    STEP(6)
    STEP(7)
    STEP(8)
    STEP(9)
    STEP(10)
    STEP(11)
    STEP(12)
    STEP(13)
    STEP(14)
    STEP(15)
    STEP(16)
    STEP(17)
    STEP(18)
    STEP(19)
    STEP(20)
    STEP(21)
    STEP(22)
    STEP(23)
    STEP(24)
    STEP(25)
    STEP(26)
    STEP(27)
    STEP(28)
    STEP(29)
    STEP(30)
    STEP(31)
    STEP(32)
    STEP(33)
    STEP(34)
#undef STEP
}

extern "C" void kernel_launch(void* const* d_in, const int* in_sizes, int n_in,
                              void* d_out, int out_size, void* d_ws, size_t ws_size,
                              hipStream_t stream) {
    Params p{};
    {
        const float** f = (const float**)&p;
        for (int i = 0; i < 22; ++i) f[i] = (const float*)d_in[i];
    }
    p.out = (float*)d_out; p.ws = (unsigned char*)d_ws; p.ws_size = (unsigned long long)ws_size;
    if (ws_size < (size_t)R_MISC * UNIT + OFF_END) { fprintf(stderr, "workspace too small\n"); return; }
    static int grid_blocks = 0;
    if (!grid_blocks) {
        int dev = 0, cus = 0, per_cu = 0;
        (void)hipGetDevice(&dev);
        (void)hipDeviceGetAttribute(&cus, hipDeviceAttributeMultiprocessorCount, dev);
        (void)hipFuncSetAttribute((const void*)k_mega, hipFuncAttributeMaxDynamicSharedMemorySize, LDS_BYTES);
        (void)hipOccupancyMaxActiveBlocksPerMultiprocessor(&per_cu, k_mega, NT, LDS_BYTES);
        if (per_cu > 1) per_cu = 1;
        grid_blocks = cus * per_cu;
        if (grid_blocks <= 0) { fprintf(stderr, "occupancy query returned 0\n"); grid_blocks = -1; }
    }
    if (grid_blocks < 0) return;
    (void)hipMemsetAsync(MISC(p, OFF_BAR), 0, 65536, stream);
#if MULTI_LAUNCH
    for (int g = 0; g <= 2 * N_PH; ++g) {
        p.ph_lo = g; p.ph_hi = g + 1;
        void* args[] = {&p};
        hipError_t e = hipLaunchCooperativeKernel((void*)k_mega, dim3(grid_blocks), dim3(NT), args, LDS_BYTES, stream);
        if (e != hipSuccess) { fprintf(stderr, "launch failed: %s\n", hipGetErrorString(e)); return; }
    }
#elif defined(DEBUG_CHECK)
    (void)hipMemsetAsync(MISC(p, OFF_CK), 0, 96 * 4, stream);
    {
        p.ph_lo = 0; p.ph_hi = 2 * N_PH + 1; p.run = 0;
        void* args[] = {&p};
        hipError_t e = hipLaunchCooperativeKernel((void*)k_mega, dim3(grid_blocks), dim3(NT), args, LDS_BYTES, stream);
        if (e != hipSuccess) { fprintf(stderr, "launch failed: %s\n", hipGetErrorString(e)); return; }
    }
    hipLaunchKernelGGL(k_report, dim3(1024), dim3(256), 0, stream, p);
#else
    p.ph_lo = 0; p.ph_hi = 2 * N_PH + 1;
    void* args[] = {&p};
    hipError_t e = hipLaunchCooperativeKernel((void*)k_mega, dim3(grid_blocks), dim3(NT), args, LDS_BYTES, stream);
    if (e != hipSuccess) fprintf(stderr, "cooperative launch failed: %s (grid %d)\n", hipGetErrorString(e), grid_blocks);
#endif
}
```

```cpp
#include <hip/hip_runtime.h>
#include <hip/hip_cooperative_groups.h>
#include <cstdio>
namespace cg = cooperative_groups;

#ifndef MULTI_LAUNCH
#define MULTI_LAUNCH 0
#ifdef WITH_DEBUG_CHECK
#define DEBUG_CHECK 1
#endif
#endif

typedef unsigned short bf16_t;
#define LAS __attribute__((address_space(3)))
#define T_TOK 16384
#define SEQ 8192
#define DM 1024
#define NIN 13440
#define NT 512
#define UNIT 33554432ull
#define LDS_STAGE 131072
#define RW_LDS_MISC (19 * 8192)
#define RW_LDS_PRM (RW_LDS_MISC + 4096)
#define LDS_BYTES (RW_LDS_MISC + 4096 + 3072)

#define PARAM_FIELDS(X) X(const float*, x) X(const float*, norm_w) X(const float*, w_in) X(const float*, b_merge) X(const float*, conv_w) X(const float*, conv_b) \
    X(const float*, gate_w) X(const float*, gate_b) X(const float*, lam) X(const float*, mu) X(const float*, w0) X(const float*, w2) \
    X(const float*, a0) X(const float*, a2) X(const float*, k_k) X(const float*, k_a) X(const float*, r_k) X(const float*, lnx_w) X(const float*, lnx_b) \
    X(const float*, w_branch) X(const float*, w_out) X(const float*, fnorm_w) X(float*, out) X(unsigned char*, ws)
struct Params {
#define X(T, n) T n;
    PARAM_FIELDS(X)
#undef X
    unsigned long long ws_size;
    int ph_lo, ph_hi, run, pad;
};
template <class T> __device__ __forceinline__ T* uni_ptr(T* p) { const unsigned long long v = (unsigned long long)p;
    const unsigned lo = __builtin_amdgcn_readfirstlane((unsigned)v), hi = __builtin_amdgcn_readfirstlane((unsigned)(v >> 32)); return (T*)(((unsigned long long)hi << 32) | lo); }
__device__ __forceinline__ Params load_params(const __attribute__((address_space(3))) Params* lp) {
    Params q;
#define X(T, n) q.n = uni_ptr(lp->n);
    PARAM_FIELDS(X)
#undef X
    q.ws_size = 0; q.ph_lo = 0; q.ph_hi = 0; return q;
}

__device__ __forceinline__ float bf2f(bf16_t b) { return __uint_as_float(((unsigned)b) << 16); }
__device__ __forceinline__ bf16_t f2bf(float f) { unsigned u = __float_as_uint(f); u += 0x7FFFu + ((u >> 16) & 1u); return (bf16_t)(u >> 16); }
__device__ __forceinline__ unsigned pk2(float lo, float hi) { return (unsigned)f2bf(lo) | ((unsigned)f2bf(hi) << 16); }
__device__ __forceinline__ float sigmoidf_(float v) { return 1.0f / (1.0f + expf(-v)); }
__device__ __forceinline__ float siluf_(float v) { return v / (1.0f + expf(-v)); }
__device__ __forceinline__ float softplusf_(float v) { return v > 20.f ? v : log1pf(expf(v)); }
__device__ __forceinline__ float fexp_(float v) { return __builtin_amdgcn_exp2f(v * 1.4426950408889634f); }
__device__ __forceinline__ float fsigmoid_(float v) { return __builtin_amdgcn_rcpf(1.0f + fexp_(-v)); }
__device__ __forceinline__ float fsilu_(float v) { return v * fsigmoid_(v); }
__device__ __forceinline__ float one_minus_exp_(float x) { const float pl = -x * (1.0f + x * (0.5f + x * (0.16666667f + x * 0.041666668f))), ex = 1.0f - fexp_(x); return x > -0.02f ? pl : ex; }
#define LAUNDER_V(x) asm volatile("" : "+v"(x))

__device__ __forceinline__ bf16_t* REG(const Params& p, int r) { return (bf16_t*)(p.ws + (size_t)r * UNIT); }
#define R_H 0
#define R_CQ 1
#define R_XA 1
#define R_LD 1
#define R_CK 2
#define R_GA 2
#define R_CV 3
#define R_BR 3
#define R_CG 4
#define R_SN 5
#define R_BK 5
#define R_BV 6
#define R_MG 6
#define R_SC 7
#define R_BG 7
#define R_CVB 8
#define R_AA 8
#define R_PM 8
#define R_LA 9
#define R_LB 10
#define R_MISC 11
#define OFF_BL 0ull
#define OFF_ROPE (4ull << 20)
#define OFF_WIN (12ull << 20)
#define OFF_WBR (OFF_WIN + 13440ull * 1024 * 2)
#define OFF_WOUT (OFF_WBR + 3ull * 1024 * 1024 * 2)
#define OFF_WG (OFF_WOUT + 1024ull * 1024 * 2)
#define OFF_BAR (OFF_WG + 2048ull * 256 * 2)
#define OFF_PROG (OFF_BAR + 16384ull)
#define OFF_AGG (OFF_BAR + 65536ull)
#define OFF_W2T (OFF_AGG + 3ull * 2 * 256 * 1024 * 4)
#define OFF_A2T (OFF_W2T + 1024ull * 64 * 2)
#define OFF_GC (OFF_A2T + 1024ull * 64 * 2)
#define OFF_BON (OFF_GC + 4096ull * 64 * 4)
#define OFF_SSQ (OFF_BON + 16384ull * 16 * 4)
#define OFF_END (OFF_SSQ + 2ull * 4 * 16384 * 4)
#define MISC(p, off) ((p).ws + (size_t)R_MISC * UNIT + (off))

__device__ __forceinline__ float wave_sum(float v) {
#pragma unroll
    for (int o = 32; o > 0; o >>= 1) v += __shfl_xor(v, o);
    return v;
}
__device__ __forceinline__ float half_sum(float v, LAS float* red) {
    v = wave_sum(v);
    const int w = threadIdx.x >> 6;
    __syncthreads();
    if ((threadIdx.x & 63) == 0) red[w] = v;
    __syncthreads();
    const int hb = (threadIdx.x >> 8) * 4;
    return (red[hb] + red[hb + 1]) + (red[hb + 2] + red[hb + 3]);
}


#define XB_TMO      128
#define XB_XCNT(j)  (256  + 64 * (j))
#define XB_XSUB(j)  (1280 + 64 * (j))
#define XB_XGEN(j)  (2304 + 64 * (j))
#define XB_TOP      3328
#define XB_TOPGEN   3392
#define XCD_BAR_WORDS 3456
#define XB_SPIN_CAP (1u << 22)
__device__ __forceinline__ unsigned xb_ld(unsigned* p)              { return __hip_atomic_load(p, __ATOMIC_RELAXED, __HIP_MEMORY_SCOPE_AGENT); }
__device__ __forceinline__ unsigned xb_add(unsigned* p, unsigned v) { return __hip_atomic_fetch_add(p, v, __ATOMIC_RELAXED, __HIP_MEMORY_SCOPE_AGENT); }
__device__ __forceinline__ unsigned xb_xcc_id() { return (unsigned)__builtin_amdgcn_s_getreg((3 << 11) | 20) & 0xFu; }
#define XB_SPIN(cond, bar) do { unsigned _sp = 0; while (cond) { __builtin_amdgcn_s_sleep(1); \
    if ((++_sp & 255u) == 0u) { if (xb_ld(&(bar)[XB_TMO])) break; if (_sp > XB_SPIN_CAP) { atomicAdd(&(bar)[XB_TMO], 1u); break; } } } } while (0)
struct XcdBarrier { unsigned* bar; unsigned x; volatile LAS unsigned* st; };
__device__ __forceinline__ XcdBarrier xcd_barrier_post(unsigned* bar, volatile LAS unsigned* st) {
    XcdBarrier b; b.bar = bar; b.x = xb_xcc_id(); b.st = st;
    if (threadIdx.x == 0) (void)xb_add(&bar[XB_XCNT(b.x)], 1u);
    return b;
}
__device__ __forceinline__ void xcd_barrier_complete(unsigned* bar, unsigned x, unsigned& nloc, unsigned& nx) {
    const unsigned G = gridDim.x * gridDim.y * gridDim.z;
    unsigned sum, cnt, mine, sp = 0u;
    for (;;) {
        sum = 0u; cnt = 0u; mine = 0u;
#pragma unroll
        for (unsigned j = 0; j < 16; ++j) { const unsigned c = xb_ld(&bar[XB_XCNT(j)]); sum += c; cnt += (c > 0u) ? 1u : 0u; mine = (j == x) ? c : mine; }
        if (sum == G) break;
        __builtin_amdgcn_s_sleep(1);
        if ((++sp & 255u) == 0u) { if (xb_ld(&bar[XB_TMO])) break; if (sp > XB_SPIN_CAP) { atomicAdd(&bar[XB_TMO], 1u); break; } }
    }
    nloc = mine > 0u ? mine : 1u; nx = cnt > 0u ? cnt : 1u;
}
__device__ __forceinline__ void xcd_barrier(const XcdBarrier& b) {
    asm volatile("s_waitcnt vmcnt(0)" ::: "memory");
    __syncthreads();
    if (threadIdx.x == 0) {
        unsigned* bar = b.bar;
        __builtin_amdgcn_s_waitcnt(0);
        unsigned nloc = b.st[0], nx = b.st[1];
        if (nloc == 0u) { xcd_barrier_complete(bar, b.x, nloc, nx); b.st[0] = nloc; b.st[1] = nx; }
        const unsigned old = xb_add(&bar[XB_XSUB(b.x)], 1u);
        const unsigned gen = old / nloc;
        if (old + 1u == (gen + 1u) * nloc) {
            __builtin_amdgcn_fence(__ATOMIC_RELEASE, "agent");
            asm volatile("s_waitcnt vmcnt(0)" ::: "memory");
            const unsigned og = xb_add(&bar[XB_TOP], 1u);
            const unsigned tg = og / nx;
            if (og + 1u == (tg + 1u) * nx) xb_add(&bar[XB_TOPGEN], 1u);
            else XB_SPIN(xb_ld(&bar[XB_TOPGEN]) == tg, bar);
            __builtin_amdgcn_fence(__ATOMIC_ACQUIRE, "agent");
            xb_add(&bar[XB_XGEN(b.x)], 1u);
            asm volatile("s_waitcnt vmcnt(0)" ::: "memory");
        } else {
            XB_SPIN(xb_ld(&bar[XB_XGEN(b.x)]) == gen, bar);
            __builtin_amdgcn_fence(__ATOMIC_ACQUIRE, "agent");
            asm volatile("s_waitcnt vmcnt(0)" ::: "memory");
        }
    }
    __syncthreads();
}

namespace pg8 {
typedef short bf16x8 __attribute__((ext_vector_type(8)));
typedef float f32x4 __attribute__((ext_vector_type(4)));
typedef unsigned u32x4 __attribute__((ext_vector_type(4)));
typedef unsigned u32x2 __attribute__((ext_vector_type(2)));
constexpr int BM = 256, BK = 64, HALF = 128, HTB = HALF * BK * 2, STAGE_BYTES = 8 * HTB, NXCD = 8, WGM = 8;

__host__ __device__ __forceinline__ int lds_byte(int r, int c) { const int st = (r >> 4) * 2 + (c >> 5), rr = r & 15, cc = c & 31, ob = rr * 64 + cc * 2; return st * 1024 + (ob ^ (((ob >> 9) & 1) << 5)); }
__host__ __device__ __forceinline__ void stage_rc(int b, int& R, int& C) { const int st = b / 1024, sb = b % 1024, swz = sb ^ (((sb >> 9) & 1) << 5); R = (st >> 1) * 16 + swz / 64; C = (st & 1) * 32 + (swz % 64) / 2; }
__host__ __device__ __forceinline__ int perm32(int rho) { const int n = rho >> 4, i = rho & 15; return 8 * (i >> 2) + 4 * n + (i & 3); }
typedef __bf16 bf16x2_t __attribute__((ext_vector_type(2)));
typedef float f32x2_t __attribute__((ext_vector_type(2)));
__device__ __forceinline__ unsigned cvt_pk_bf16(float lo, float hi) { const f32x2_t v = {lo, hi}; const bf16x2_t b = __builtin_convertvector(v, bf16x2_t); return __builtin_bit_cast(unsigned, b); }

struct Unit { int pm, pn, z; };

struct StaticOrder {
    int nM, nN, nwg, G, c;
    __device__ __forceinline__ void init(int M, int N, int G_, int c_) { nM = M / BM; nN = N / BM; nwg = nM * nN; G = G_; c = c_; }
    __device__ __forceinline__ bool next(int i, Unit& u) const {
        const long L = (long)i * G + c; if (L >= nwg) return false;
        int wgid = (int)L; { const int q = nwg / NXCD, r = nwg % NXCD, xcd = wgid % NXCD, off = wgid / NXCD; wgid = (xcd < r ? xcd * (q + 1) : r * (q + 1) + (xcd - r) * q) + off; }
        const int nig = WGM * nN, gid = wgid / nig, fm = gid * WGM, gsz = (nM - fm) < WGM ? (nM - fm) : WGM;
        u.pm = fm + ((wgid % nig) % gsz); u.pn = (wgid % nig) / gsz; u.z = 0; return true;
    }
};
template <int NZ> struct StaticOrderZ {
    StaticOrder s;
    __device__ __forceinline__ bool next(int i, Unit& u) const { const int q = i / NZ; if (!s.next(q, u)) return false; u.z = i - q * NZ; return true; }
};

template <class G, class Epi, class Sched, bool ALIGN_EPI, bool SP2>
__device__ __forceinline__ void gemm_phase(LAS unsigned char* lds, const G& g, const Sched& S, const Epi& E) {
    int tid = threadIdx.x; LAUNDER_V(tid);
    const int wid = __builtin_amdgcn_readfirstlane(tid >> 6), lane = tid & 63, wr = wid >> 2, wc = wid & 3, fr = lane & 15, fq = lane >> 4;
    const int nt = g.K / BK;
    unsigned voffA[2], voffB[2];
#pragma unroll
    for (int i = 0; i < 2; ++i) { int R, C; stage_rc(tid * 16 + i * 8192, R, C); const int Rb = Epi::PERM ? ((R & ~31) + perm32(R & 31)) : R;
        voffA[i] = (unsigned)(R * g.lda + C) * 2u; voffB[i] = (unsigned)(Rb * g.ldb + C) * 2u; }
    const size_t hstepA = (size_t)HALF * g.lda * 2, hstepB = (size_t)HALF * g.ldb * 2;
    const unsigned ldsw = (unsigned)wid * 1024u;
    const int aoff = lds_byte(wr * 64 + fr, fq * 8), boff = lds_byte(wc * 32 + fr, fq * 8);
#define PG8_SA(b, h) (((b) * 2 + (h)) * HTB)
#define PG8_SB(b, h) ((4 + (b) * 2 + (h)) * HTB)
#define PG8_STAGE(bufoff, gbase, voff) do { _Pragma("unroll") for (int _i = 0; _i < 2; ++_i) \
        __builtin_amdgcn_global_load_lds((const unsigned*)((const char*)(gbase) + (voff)[_i]), (LAS unsigned*)(lds + (bufoff) + ldsw + _i * 8192), 16, 0, 0); } while (0)
#define PG8_LDA(dst, b, h) do { _Pragma("unroll") for (int m = 0; m < 4; ++m) _Pragma("unroll") for (int k = 0; k < 2; ++k) dst[m][k] = *(const LAS bf16x8*)(lds + PG8_SA(b, h) + aoff + m * 2048 + k * 1024); } while (0)
#define PG8_LDB(dst, b, h) do { _Pragma("unroll") for (int n = 0; n < 2; ++n) _Pragma("unroll") for (int k = 0; k < 2; ++k) dst[n][k] = *(const LAS bf16x8*)(lds + PG8_SB(b, h) + boff + n * 2048 + k * 1024); } while (0)
#define PG8_MMA(ai, bj, At, Bt) do { __builtin_amdgcn_s_setprio(1); _Pragma("unroll") for (int m = 0; m < 4; ++m) _Pragma("unroll") for (int n = 0; n < 2; ++n) _Pragma("unroll") for (int k = 0; k < 2; ++k) \
        acc[ai][bj][m][n] = __builtin_amdgcn_mfma_f32_16x16x32_bf16(Bt[n][k], At[m][k], acc[ai][bj][m][n], 0, 0, 0); __builtin_amdgcn_s_setprio(0); } while (0)
#ifdef SAFE_GEMM
#define PG8_WAIT_V(n) asm volatile("s_waitcnt vmcnt(0)" ::: "memory")
#else
#define PG8_WAIT_V(n) asm volatile("s_waitcnt vmcnt(" #n ")" ::: "memory")
#endif
#define PG8_WAIT_L(n) asm volatile("s_waitcnt lgkmcnt(" #n ")" ::: "memory")
#define PG8_BAR __builtin_amdgcn_s_barrier()
#define PG8_SCHED __builtin_amdgcn_sched_barrier(0)
    Unit cur, nxt; int ui = 0;
    if (!S.next(0, cur)) return;
    f32x4 acc[2][2][4][2];
#pragma unroll
    for (int a = 0; a < 2; ++a)
#pragma unroll
        for (int b = 0; b < 2; ++b)
#pragma unroll
            for (int m = 0; m < 4; ++m)
#pragma unroll
                for (int n = 0; n < 2; ++n) acc[a][b][m][n] = (f32x4){0.f, 0.f, 0.f, 0.f};
    bf16x8 At[4][2], B0[2][2], B1[2][2];
    {
        const char* cA0 = g.aptr(cur, 0); const char* cB0 = g.bptr(cur, 0); const char* cA1 = g.aptr(cur, 1); const char* cB1 = g.bptr(cur, 1);
        static_assert(SP2, "only the SP2 loop is kept");
        PG8_STAGE(PG8_SB(0, 0), cB0, voffB); PG8_STAGE(PG8_SB(0, 1), cB0 + hstepB, voffB); PG8_STAGE(PG8_SA(0, 0), cA0, voffA); PG8_STAGE(PG8_SA(0, 1), cA0 + hstepA, voffA);
        if (wr == 1) PG8_BAR;
        PG8_WAIT_V(2); PG8_BAR;
        PG8_STAGE(PG8_SB(1, 0), cB1, voffB); PG8_STAGE(PG8_SA(1, 0), cA1, voffA); PG8_STAGE(PG8_SB(1, 1), cB1 + hstepB, voffB);
        PG8_WAIT_V(6); PG8_BAR;
    }
    for (;;) {
        const bool has_next = S.next(ui + 1, nxt);
        const Unit nx = has_next ? nxt : cur;
        for (int t = 0; t < nt; t += 2) {
            const bool last = (t == nt - 2);
            const char* a1 = g.aptr(cur, t + 1);
            const char* a2 = last ? g.aptr(nx, 0) : g.aptr(cur, t + 2); const char* b2 = last ? g.bptr(nx, 0) : g.bptr(cur, t + 2);
            const char* a3 = last ? g.aptr(nx, 1) : g.aptr(cur, t + 3); const char* b3 = last ? g.bptr(nx, 1) : g.bptr(cur, t + 3);
            PG8_LDB(B0, 0, 0); PG8_LDB(B1, 0, 1); PG8_SCHED; PG8_LDA(At, 0, 0); PG8_STAGE(PG8_SA(1, 1), a1 + hstepA, voffA);
            PG8_WAIT_V(8); PG8_WAIT_L(0); PG8_BAR; PG8_MMA(0, 0, At, B0); PG8_MMA(0, 1, At, B1); PG8_BAR; PG8_SCHED;
            PG8_LDA(At, 0, 1); PG8_STAGE(PG8_SB(0, 0), b2, voffB); PG8_STAGE(PG8_SB(0, 1), b2 + hstepB, voffB); PG8_STAGE(PG8_SA(0, 0), a2, voffA);
            PG8_WAIT_V(8); PG8_WAIT_L(0); PG8_BAR; PG8_MMA(1, 0, At, B0); PG8_MMA(1, 1, At, B1); PG8_BAR; PG8_SCHED;
            PG8_LDB(B0, 1, 0); PG8_LDB(B1, 1, 1); PG8_SCHED; PG8_LDA(At, 1, 0); PG8_STAGE(PG8_SA(0, 1), a2 + hstepA, voffA);
            PG8_WAIT_V(8); PG8_WAIT_L(0); PG8_BAR; PG8_MMA(0, 0, At, B0); PG8_MMA(0, 1, At, B1); PG8_BAR; PG8_SCHED;
            PG8_LDA(At, 1, 1); PG8_STAGE(PG8_SB(1, 0), b3, voffB); PG8_STAGE(PG8_SB(1, 1), b3 + hstepB, voffB); PG8_STAGE(PG8_SA(1, 0), a3, voffA);
            PG8_WAIT_V(8); PG8_WAIT_L(0); PG8_BAR; PG8_MMA(1, 0, At, B0); PG8_MMA(1, 1, At, B1); PG8_BAR; PG8_SCHED;
        }
        if constexpr (ALIGN_EPI) { if (wr == 0) PG8_BAR; }
        if constexpr (!Epi::AFTER_DRAIN) E(acc, cur, wr, wc, fr, fq);
        if (!has_next) break;
#pragma unroll
        for (int a = 0; a < 2; ++a)
#pragma unroll
            for (int b = 0; b < 2; ++b)
#pragma unroll
                for (int m = 0; m < 4; ++m)
#pragma unroll
                    for (int n = 0; n < 2; ++n) acc[a][b][m][n] = (f32x4){0.f, 0.f, 0.f, 0.f};
        cur = nxt; ++ui;
        if constexpr (ALIGN_EPI) { if (wr == 1) PG8_BAR; }
    }
    PG8_WAIT_V(0);
    if constexpr (!ALIGN_EPI) { if (wr == 0) PG8_BAR; }
    PG8_BAR;
    if constexpr (Epi::AFTER_DRAIN) E.fused(acc, cur, wr, wc, fr, fq, lds, wid, lane);
#undef PG8_SA
#undef PG8_SB
#undef PG8_STAGE
#undef PG8_LDA
#undef PG8_LDB
#undef PG8_MMA
#undef PG8_WAIT_V
#undef PG8_WAIT_L
#undef PG8_BAR
#undef PG8_SCHED
}
}
using pg8::f32x4; using pg8::u32x4; using pg8::Unit;

struct GPlain {
    const char* A; const char* Bt; int K, lda, ldb;
    __device__ __forceinline__ const char* aptr(const Unit& u, int t) const { return A + ((size_t)u.pm * 256 * lda + (size_t)t * 64) * 2; }
    __device__ __forceinline__ const char* bptr(const Unit& u, int t) const { return Bt + ((size_t)u.pn * 256 * ldb + (size_t)t * 64) * 2; }
};
struct GGate {
    const char* A; const char* Bt; int K, lda, ldb;
    __device__ __forceinline__ const char* aptr(const Unit& u, int t) const { return A + ((size_t)u.pm * 256 * 1024 + (size_t)(u.pn >> 1) * 256 + (size_t)t * 64) * 2; }
    __device__ __forceinline__ const char* bptr(const Unit& u, int t) const { return Bt + ((size_t)u.pn * 256 * 256 + (size_t)t * 64) * 2; }
};
struct GMerge6 {
    const char* H; const char* Wm; const char* Y0; const char* Y1; const char* Y2; const char* Bt; int K, lda, ldb;
    __device__ __forceinline__ const char* aptr(const Unit& u, int t) const { const char* y = u.z < 3 ? H : (u.z == 3 ? Y0 : (u.z == 4 ? Y1 : Y2)); return y + ((size_t)u.pm * 256 * 1024 + (size_t)t * 64) * 2; }
    __device__ __forceinline__ const char* bptr(const Unit& u, int t) const { return u.z < 3 ? Wm + ((size_t)(u.z * 1024 + u.pn * 256) * 1024 + (size_t)t * 64) * 2 : Bt + ((size_t)(u.z - 3) * 1024 * 1024 + (size_t)u.pn * 256 * 1024 + (size_t)t * 64) * 2; }
};
struct GMerge {
    const char* Y0; const char* Y1; const char* Y2; const char* Bt; int K, lda, ldb;
    __device__ __forceinline__ const char* aptr(const Unit& u, int t) const { const char* y = u.z == 0 ? Y0 : (u.z == 1 ? Y1 : Y2); return y + ((size_t)u.pm * 256 * 1024 + (size_t)t * 64) * 2; }
    __device__ __forceinline__ const char* bptr(const Unit& u, int t) const { return Bt + ((size_t)u.z * 1024 * 1024 + (size_t)u.pn * 256 * 1024 + (size_t)t * 64) * 2; }
};

__device__ __forceinline__ u32x4 pack8(const f32x4& v0, const f32x4& v1) {
    u32x4 w; w.x = pg8::cvt_pk_bf16(v0[0], v0[1]); w.y = pg8::cvt_pk_bf16(v0[2], v0[3]); w.z = pg8::cvt_pk_bf16(v1[0], v1[1]); w.w = pg8::cvt_pk_bf16(v1[2], v1[3]); return w;
}
__device__ __forceinline__ void unpack8(const u32x4& w, f32x4& v0, f32x4& v1) {
    v0[0] = __uint_as_float(w.x << 16); v0[1] = __uint_as_float(w.x & 0xffff0000u); v0[2] = __uint_as_float(w.y << 16); v0[3] = __uint_as_float(w.y & 0xffff0000u);
    v1[0] = __uint_as_float(w.z << 16); v1[1] = __uint_as_float(w.z & 0xffff0000u); v1[2] = __uint_as_float(w.w << 16); v1[3] = __uint_as_float(w.w & 0xffff0000u);
}
struct WtBuf { __amdgpu_buffer_rsrc_t r; const char* b; };
__device__ __forceinline__ WtBuf wt_make(const void* base) { WtBuf w; w.r = __builtin_amdgcn_make_buffer_rsrc((void*)base, 0, 0x7fffffff, 0x00020000); w.b = (const char*)base; return w; }
__device__ __forceinline__ void wt_st16(const WtBuf& w, const void* ptr, u32x4 v) { __builtin_amdgcn_raw_buffer_store_b128(v, w.r, (unsigned)((const char*)ptr - w.b), 0, 16); }
__device__ __forceinline__ void wt_st8(const WtBuf& w, const void* ptr, pg8::u32x2 v) { __builtin_amdgcn_raw_buffer_store_b64(v, w.r, (unsigned)((const char*)ptr - w.b), 0, 16); }
__device__ __forceinline__ void wt16(const void* base, const void* ptr, u32x4 v) { wt_st16(wt_make(base), ptr, v); }
__device__ __forceinline__ void wt16f(const void* base, const void* ptr, f32x4 v) { wt_st16(wt_make(base), ptr, __builtin_bit_cast(u32x4, v)); }
__device__ __forceinline__ void wt8(const void* base, const void* ptr, pg8::u32x2 v) { wt_st8(wt_make(base), ptr, v); }
struct EpiC {
    static constexpr bool PERM = true, AFTER_DRAIN = false;
    unsigned char* ws; const float2* tab;
    __device__ __forceinline__ void operator()(const f32x4 (&acc_)[2][2][4][2], const Unit& u, int wr, int wc, int fr, int fq) const {
        f32x4 (&acc)[2][2][4][2] = const_cast<f32x4 (&)[2][2][4][2]>(acc_);
        const int which = u.pn >> 2, head = u.pn & 3;
        bf16_t* base = (bf16_t*)(ws + (size_t)(R_CQ + which) * UNIT);
        const int row0 = u.pm * 256 + wr * 64 + fr, d0 = wc * 32 + 8 * fq;
        if (which < 2) {
            const float sc = which == 1 ? 0.0625f : 1.0f;
#pragma unroll
            for (int ai = 0; ai < 2; ++ai)
#pragma unroll
                for (int m = 0; m < 4; ++m) {
                    const int row = row0 + ai * 128 + m * 16;
                    const f32x4* tp = (const f32x4*)(tab + (size_t)(row & (SEQ - 1)) * 128 + d0);
                    const f32x4 c0 = tp[0], c1 = tp[1], c2 = tp[2], c3 = tp[3];
                    const f32x4 lo0 = acc[ai][0][m][0], lo1 = acc[ai][0][m][1], hi0 = acc[ai][1][m][0], hi1 = acc[ai][1][m][1];
                    f32x4 a0, a1, b0, b1;
                    a0[0] = (lo0[0] * c0[0] - hi0[0] * c0[1]) * sc; b0[0] = (lo0[0] * c0[1] + hi0[0] * c0[0]) * sc;
                    a0[1] = (lo0[1] * c0[2] - hi0[1] * c0[3]) * sc; b0[1] = (lo0[1] * c0[3] + hi0[1] * c0[2]) * sc;
                    a0[2] = (lo0[2] * c1[0] - hi0[2] * c1[1]) * sc; b0[2] = (lo0[2] * c1[1] + hi0[2] * c1[0]) * sc;
                    a0[3] = (lo0[3] * c1[2] - hi0[3] * c1[3]) * sc; b0[3] = (lo0[3] * c1[3] + hi0[3] * c1[2]) * sc;
                    a1[0] = (lo1[0] * c2[0] - hi1[0] * c2[1]) * sc; b1[0] = (lo1[0] * c2[1] + hi1[0] * c2[0]) * sc;
                    a1[1] = (lo1[1] * c2[2] - hi1[1] * c2[3]) * sc; b1[1] = (lo1[1] * c2[3] + hi1[1] * c2[2]) * sc;
                    a1[2] = (lo1[2] * c3[0] - hi1[2] * c3[1]) * sc; b1[2] = (lo1[2] * c3[1] + hi1[2] * c3[0]) * sc;
                    a1[3] = (lo1[3] * c3[2] - hi1[3] * c3[3]) * sc; b1[3] = (lo1[3] * c3[3] + hi1[3] * c3[2]) * sc;
                    acc[ai][0][m][0] = a0; acc[ai][0][m][1] = a1; acc[ai][1][m][0] = b0; acc[ai][1][m][1] = b1;
                }
        }
#pragma unroll
        for (int ai = 0; ai < 2; ++ai)
#pragma unroll
            for (int m = 0; m < 4; ++m) {
                const int row = row0 + ai * 128 + m * 16;
                bf16_t* rowp = base + (size_t)row * DM + head * 256 + d0;
                const f32x4 lo0 = acc[ai][0][m][0], lo1 = acc[ai][0][m][1], hi0 = acc[ai][1][m][0], hi1 = acc[ai][1][m][1];
                if (which != 2) { wt16(ws, rowp, pack8(lo0, lo1)); wt16(ws, rowp + 128, pack8(hi0, hi1)); }
                if (which == 1 || which == 2) {
                    const int j = wr * 64 + fr + ai * 128 + m * 16;
                    const float sc = which == 1 ? exp2f(log2f(1.0f - exp2f(-5.0f - (float)head)) * (float)(255 - j)) : 1.0f;
                    bf16_t* tb = (bf16_t*)(ws + (size_t)(which == 1 ? 5 : 6) * UNIT) + (size_t)(u.pm * 4 + head) * 65536 + j;
#pragma unroll
                    for (int q = 0; q < 4; ++q) {
                        tb[(size_t)(d0 + q) * 256] = f2bf(lo0[q] * sc); tb[(size_t)(d0 + 4 + q) * 256] = f2bf(lo1[q] * sc);
                        tb[(size_t)(128 + d0 + q) * 256] = f2bf(hi0[q] * sc); tb[(size_t)(128 + d0 + 4 + q) * 256] = f2bf(hi1[q] * sc);
                    }
                }
            }
    }
};
struct EpiAB {
    static constexpr bool PERM = true, AFTER_DRAIN = false;
    unsigned char* ws; bf16_t* bl;
    const unsigned* waitw = nullptr; unsigned need = 0u; int fpm = -1, fpn = -1;
    __device__ __forceinline__ void operator()(const f32x4 (&acc)[2][2][4][2], const Unit& u, int wr, int wc, int fr, int fq) const {
        const int row0 = u.pm * 256 + wr * 64 + fr, c0 = wc * 32 + 8 * fq;
        if (waitw != nullptr && u.pm == fpm && u.pn == fpn) {
            for (unsigned spins = 0; spins < (1u << 22); ++spins) { if ((unsigned)__builtin_amdgcn_readfirstlane(__hip_atomic_load(waitw, __ATOMIC_RELAXED, __HIP_MEMORY_SCOPE_AGENT)) >= need) break; __builtin_amdgcn_s_sleep(2); }
            asm volatile("" ::: "memory");
        }
        const WtBuf wt = wt_make(ws);
        if (u.pn < 24) {
            const int g = u.pn >> 2; const int rg = 1 + g + (g >= 3 ? 1 : 0);
            bf16_t* base = (bf16_t*)(ws + (size_t)rg * UNIT) + (u.pn & 3) * 256 + c0;
#pragma unroll
            for (int ai = 0; ai < 2; ++ai)
#pragma unroll
                for (int m = 0; m < 4; ++m) { bf16_t* rowp = base + (size_t)(row0 + ai * 128 + m * 16) * DM;
#pragma unroll
                    for (int bj = 0; bj < 2; ++bj) wt_st16(wt, rowp + bj * 128, pack8(acc[ai][bj][m][0], acc[ai][bj][m][1])); }
        } else {
#pragma unroll
            for (int ai = 0; ai < 2; ++ai)
#pragma unroll
                for (int m = 0; m < 4; ++m) *(u32x4*)(bl + (size_t)(row0 + ai * 128 + m * 16) * 128 + c0) = pack8(acc[ai][0][m][0], acc[ai][0][m][1]);
        }
    }
};
struct EpiGate {
    static constexpr bool PERM = true, AFTER_DRAIN = false;
    const bf16_t* cv; bf16_t* la; bf16_t* lb; const float* gb; const float* lam;
    __device__ __forceinline__ void operator()(const f32x4 (&acc)[2][2][4][2], const Unit& u, int wr, int wc, int fr, int fq) const {
        const int row0 = u.pm * 256 + wr * 64 + fr, ch0 = (u.pn >> 1) * 256 + (u.pn & 1) * 128 + wc * 32 + 8 * fq;
        float sp[8], b0[8], b1[8];
#pragma unroll
        for (int j = 0; j < 8; ++j) { const float z = -lam[ch0 + j];
            sp[j] = -8.0f * (fmaxf(z, 0.f) + __builtin_amdgcn_logf(1.0f + fexp_(-fabsf(z))) * 0.6931471805599453f); b0[j] = gb[ch0 + j]; b1[j] = gb[DM + ch0 + j]; }
#pragma unroll
        for (int ai = 0; ai < 2; ++ai)
#pragma unroll
            for (int m = 0; m < 4; ++m) {
                const int row = row0 + ai * 128 + m * 16; const size_t o = (size_t)row * DM + ch0;
                f32x4 c0, c1; unpack8(*(const u32x4*)(cv + o), c0, c1);
                f32x4 A0, A1, B0, B1;
                const bool first = (row & (SEQ - 1)) == 0;
#pragma unroll
                for (int j = 0; j < 8; ++j) {
                    const float g0 = (j < 4 ? acc[ai][0][m][0][j & 3] : acc[ai][0][m][1][j & 3]) + b0[j];
                    const float g1 = (j < 4 ? acc[ai][1][m][0][j & 3] : acc[ai][1][m][1][j & 3]) + b1[j];
                    const float cvj = j < 4 ? c0[j & 3] : c1[j & 3];
                    const float log_a = fsigmoid_(g0) * sp[j];
                    float mult = __builtin_amdgcn_sqrtf(fmaxf(one_minus_exp_(2.0f * log_a), 0.f)); if (first) mult = 1.0f;
                    const float bb = mult * fsigmoid_(g1) * cvj;
                    if (j < 4) { A0[j & 3] = log_a; B0[j & 3] = bb; } else { A1[j & 3] = log_a; B1[j & 3] = bb; }
                }
                *(u32x4*)(la + o) = pack8(A0, A1); *(u32x4*)(lb + o) = pack8(B0, B1);
            }
    }
};
struct EpiPM {
    static constexpr bool PERM = true, AFTER_DRAIN = false;
    bf16_t* pm; const float* bias;
    __device__ __forceinline__ void operator()(const f32x4 (&acc)[2][2][4][2], const Unit& u, int wr, int wc, int fr, int fq) const {
        const int row0 = u.pm * 256 + wr * 64 + fr, c0 = wc * 32 + 8 * fq;
        bf16_t* base = pm + (size_t)(u.pn >> 2) * (UNIT / 2) + (u.pn & 3) * 256 + c0; const float* bp = bias + u.pn * 256 + c0;
#pragma unroll
        for (int bj = 0; bj < 2; ++bj) {
            const f32x4 bv0 = *(const f32x4*)(bp + bj * 128), bv1 = *(const f32x4*)(bp + bj * 128 + 4);
#pragma unroll
            for (int ai = 0; ai < 2; ++ai)
#pragma unroll
                for (int m = 0; m < 4; ++m) {
                    f32x4 v0 = acc[ai][bj][m][0] + bv0, v1 = acc[ai][bj][m][1] + bv1;
#pragma unroll
                    for (int j = 0; j < 4; ++j) { v0[j] = fsigmoid_(v0[j]); v1[j] = fsigmoid_(v1[j]); }
                    *(u32x4*)(base + (size_t)(row0 + ai * 128 + m * 16) * DM + bj * 128) = pack8(v0, v1);
                }
        }
    }
};
struct EpiMerge {
    static constexpr bool PERM = true, AFTER_DRAIN = false;
    const bf16_t* pm; bf16_t* mg;
    __device__ __forceinline__ void operator()(const f32x4 (&acc)[2][2][4][2], const Unit& u, int wr, int wc, int fr, int fq) const {
        const int row0 = u.pm * 256 + wr * 64 + fr, c0 = u.pn * 256 + wc * 32 + 8 * fq;
        const bf16_t* gp = pm + (size_t)u.z * (UNIT / 2);
#pragma unroll
        for (int ai = 0; ai < 2; ++ai)
#pragma unroll
            for (int m = 0; m < 4; ++m)
#pragma unroll
                for (int bj = 0; bj < 2; ++bj) {
                    const size_t o = (size_t)(row0 + ai * 128 + m * 16) * DM + c0 + bj * 128;
                    f32x4 g0, g1; unpack8(*(const u32x4*)(gp + o), g0, g1);
                    f32x4 v0 = g0 * acc[ai][bj][m][0], v1 = g1 * acc[ai][bj][m][1];
                    if (u.z > 0) { f32x4 p0, p1; unpack8(*(const u32x4*)(mg + o), p0, p1); v0 += p0; v1 += p1; }
                    *(u32x4*)(mg + o) = pack8(v0, v1);
                }
    }
};
struct EpiMerge6 {
    static constexpr bool PERM = true, AFTER_DRAIN = false;
    bf16_t* pm; bf16_t* mg; const float* bias;
    __device__ __forceinline__ void operator()(const f32x4 (&acc)[2][2][4][2], const Unit& u, int wr, int wc, int fr, int fq) const {
        const int row0 = u.pm * 256 + wr * 64 + fr, c0 = u.pn * 256 + wc * 32 + 8 * fq;
        if (u.z < 3) {
            bf16_t* gp = pm + (size_t)u.z * (UNIT / 2); const float* bp = bias + u.z * 1024 + c0;
#pragma unroll
            for (int bj = 0; bj < 2; ++bj) {
                const f32x4 bv0 = *(const f32x4*)(bp + bj * 128), bv1 = *(const f32x4*)(bp + bj * 128 + 4);
#pragma unroll
                for (int ai = 0; ai < 2; ++ai)
#pragma unroll
                    for (int m = 0; m < 4; ++m) {
                        f32x4 v0 = acc[ai][bj][m][0] + bv0, v1 = acc[ai][bj][m][1] + bv1;
#pragma unroll
                        for (int j = 0; j < 4; ++j) { v0[j] = fsigmoid_(v0[j]); v1[j] = fsigmoid_(v1[j]); }
                        *(u32x4*)(gp + (size_t)(row0 + ai * 128 + m * 16) * DM + c0 + bj * 128) = pack8(v0, v1);
                    }
            }
        } else {
            const bf16_t* gp = pm + (size_t)(u.z - 3) * (UNIT / 2);
#pragma unroll
            for (int ai = 0; ai < 2; ++ai)
#pragma unroll
                for (int m = 0; m < 4; ++m)
#pragma unroll
                    for (int bj = 0; bj < 2; ++bj) {
                        const size_t o = (size_t)(row0 + ai * 128 + m * 16) * DM + c0 + bj * 128;
                        f32x4 g0, g1; unpack8(*(const u32x4*)(gp + o), g0, g1);
                        f32x4 v0 = g0 * acc[ai][bj][m][0], v1 = g1 * acc[ai][bj][m][1];
                        if (u.z > 3) { f32x4 p0, p1; unpack8(*(const u32x4*)(mg + o), p0, p1); v0 += p0; v1 += p1; }
                        *(u32x4*)(mg + o) = pack8(v0, v1);
                    }
        }
    }
};
struct EpiOut {
    static constexpr bool PERM = false, AFTER_DRAIN = false;
    const float* xin; float* xout;
    __device__ __forceinline__ void operator()(const f32x4 (&acc)[2][2][4][2], const Unit& u, int wr, int wc, int fr, int fq) const {
        const int row0 = u.pm * 256 + wr * 64 + fr, col0 = u.pn * 256 + wc * 32 + 4 * fq;
#pragma unroll
        for (int ai = 0; ai < 2; ++ai)
#pragma unroll
            for (int m = 0; m < 4; ++m) { const size_t ro = (size_t)(row0 + ai * 128 + m * 16) * DM + col0;
#pragma unroll
                for (int bj = 0; bj < 2; ++bj)
#pragma unroll
                    for (int n = 0; n < 2; ++n) { const size_t o = ro + bj * 128 + n * 16; *(f32x4*)(xout + o) = *(const f32x4*)(xin + o) + acc[ai][bj][m][n]; } }
    }
};
struct EpiOutNorm {
    static constexpr bool PERM = false, AFTER_DRAIN = true;
    const float* xin; float* xout; bf16_t* hout; const float* nw; float* ssq; unsigned* ctr; int last;
    __device__ __forceinline__ void fused(f32x4 (&acc)[2][2][4][2], const Unit& u, int wr, int wc, int fr, int fq, LAS unsigned char* lds, int wid, int lane) const {
        LAS float* P = (LAS float*)lds;
        LAS float* RS = (LAS float*)(lds + 4096);
        const int col0 = u.pn * 256 + wc * 32 + 4 * fq, tid = wid * 64 + lane;
#pragma unroll
        for (int ai = 0; ai < 2; ++ai)
#pragma unroll
            for (int m = 0; m < 4; ++m) { const int i = wr * 64 + fr + ai * 128 + m * 16; const size_t ro = (size_t)(u.pm * 256 + i) * DM + col0; float sq = 0.f;
#pragma unroll
                for (int bj = 0; bj < 2; ++bj)
#pragma unroll
                    for (int n = 0; n < 2; ++n) { const size_t o = ro + bj * 128 + n * 16; const f32x4 v = *(const f32x4*)(xin + o) + acc[ai][bj][m][n]; acc[ai][bj][m][n] = v;
                        sq += (v[0] * v[0] + v[1] * v[1]) + (v[2] * v[2] + v[3] * v[3]); }
                sq += __shfl_xor(sq, 16); sq += __shfl_xor(sq, 32);
                if (fq == 0) P[i * 4 + wc] = sq; }
        asm volatile("s_waitcnt lgkmcnt(0)" ::: "memory"); __builtin_amdgcn_s_barrier(); asm volatile("" ::: "memory");
        if (tid < 256) { const f32x4 q = *(const LAS f32x4*)(P + tid * 4);
            __hip_atomic_store((unsigned*)(ssq + (size_t)u.pn * T_TOK + u.pm * 256 + tid), __float_as_uint((q[0] + q[1]) + (q[2] + q[3])), __ATOMIC_RELAXED, __HIP_MEMORY_SCOPE_AGENT); }
        asm volatile("s_waitcnt vmcnt(0)" ::: "memory"); __syncthreads();
        if (tid == 0) {
            __hip_atomic_fetch_add(ctr + u.pm, 1u, __ATOMIC_RELAXED, __HIP_MEMORY_SCOPE_AGENT);
            for (unsigned spins = 0; spins < (1u << 22); ++spins) { if (__hip_atomic_load(ctr + u.pm, __ATOMIC_RELAXED, __HIP_MEMORY_SCOPE_AGENT) >= 4u) break; __builtin_amdgcn_s_sleep(2); }
            __builtin_amdgcn_fence(__ATOMIC_ACQUIRE, "agent"); asm volatile("s_waitcnt vmcnt(0)" ::: "memory");
        }
        __syncthreads();
        if (tid < 256) { float t4 = 0.f;
#pragma unroll
            for (int k = 0; k < 4; ++k) t4 += ssq[(size_t)k * T_TOK + u.pm * 256 + tid];
            RS[tid] = rsqrtf(t4 * (1.0f / DM) + 1e-6f); }
        asm volatile("s_waitcnt lgkmcnt(0)" ::: "memory"); __builtin_amdgcn_s_barrier(); asm volatile("" ::: "memory");
        f32x4 wv[2][2];
#pragma unroll
        for (int bj = 0; bj < 2; ++bj)
#pragma unroll
            for (int n = 0; n < 2; ++n) wv[bj][n] = *(const f32x4*)(nw + col0 + bj * 128 + n * 16);
#pragma unroll
        for (int ai = 0; ai < 2; ++ai)
#pragma unroll
            for (int m = 0; m < 4; ++m) { const int i = wr * 64 + fr + ai * 128 + m * 16; const size_t ro = (size_t)(u.pm * 256 + i) * DM + col0; const float rs = RS[i];
#pragma unroll
                for (int bj = 0; bj < 2; ++bj)
#pragma unroll
                    for (int n = 0; n < 2; ++n) { const size_t o = ro + bj * 128 + n * 16; const f32x4 v = acc[ai][bj][m][n] * rs * wv[bj][n];
                        if (last) *(f32x4*)(xout + o) = v;
                        else { *(f32x4*)(xout + o) = acc[ai][bj][m][n]; pg8::u32x2 w; w.x = pg8::cvt_pk_bf16(v[0], v[1]); w.y = pg8::cvt_pk_bf16(v[2], v[3]); *(pg8::u32x2*)(hout + o) = w; } } }
    }
};

__device__ __forceinline__ void transpose_item(const float* W, int ldw, int K, bf16_t* WT, int k0, int n0, int orow0, LAS float* scr, int lane) {
    f32x4 v[8];
#pragma unroll
    for (int i = 0; i < 8; ++i) v[i] = *(const f32x4*)(W + (size_t)(k0 + 8 * i + (lane >> 3)) * ldw + n0 + (lane & 7) * 4);
#pragma unroll
    for (int i = 0; i < 8; ++i) { LAS float* d = scr + (8 * i + (lane >> 3)) * 33 + (lane & 7) * 4; d[0] = v[i][0]; d[1] = v[i][1]; d[2] = v[i][2]; d[3] = v[i][3]; }
    asm volatile("s_waitcnt lgkmcnt(0)" ::: "memory");
    const int c = lane & 7;
#pragma unroll
    for (int j = 0; j < 4; ++j) { const int n = (lane >> 3) + 8 * j; const LAS float* s = scr + (8 * c) * 33 + n;
        u32x4 o; o.x = pg8::cvt_pk_bf16(s[0 * 33], s[1 * 33]); o.y = pg8::cvt_pk_bf16(s[2 * 33], s[3 * 33]); o.z = pg8::cvt_pk_bf16(s[4 * 33], s[5 * 33]); o.w = pg8::cvt_pk_bf16(s[6 * 33], s[7 * 33]);
        *(u32x4*)(WT + (size_t)(orow0 + n) * K + k0 + 8 * c) = o; }
    asm volatile("s_waitcnt lgkmcnt(0)" ::: "memory");
}
__device__ void ph_weights(const Params& p, int l, int vb, int nvb, LAS unsigned char* lds, const unsigned* waitw, unsigned need) {
    const int wave = threadIdx.x >> 6, lane = threadIdx.x & 63;
    LAS float* scr = (LAS float*)(lds + wave * 16384);
    const int gw = vb * 8 + wave, NGW = nvb * 8;
    constexpr int I_IN = 16 * (NIN / 32), I_BR = 3 * 16 * 32, I_OUT = 16 * 32, I_G = 8 * 4 * 8, I_L = 2 * 32;
    bf16_t* win = (bf16_t*)MISC(p, OFF_WIN); bf16_t* wbr = (bf16_t*)MISC(p, OFF_WBR); bf16_t* wout = (bf16_t*)MISC(p, OFF_WOUT); bf16_t* wg = (bf16_t*)MISC(p, OFF_WG);
    for (int it = gw; it < I_IN + I_BR + I_OUT + I_G + I_L; it += NGW) {
        int r = it;
        if (r >= I_IN + I_BR + I_OUT + I_G) { r -= I_IN + I_BR + I_OUT + I_G; const int which = r >> 5, nb = r & 31;
            transpose_item((which ? p.a2 : p.w2) + (size_t)l * 64 * DM, DM, 64, (bf16_t*)MISC(p, which ? OFF_A2T : OFF_W2T), 0, nb * 32, nb * 32, scr, lane); continue; }
        if (r < I_IN) { const int kb = r / (NIN / 32), nb = r % (NIN / 32); transpose_item(p.w_in + (size_t)l * DM * NIN, NIN, DM, win, kb * 64, nb * 32, nb * 32, scr, lane); continue; } r -= I_IN;
        if (r < I_BR) { const int z = r / 512, q = r % 512, kb = q / 32, nb = q % 32; transpose_item(p.w_branch + ((size_t)l * 3 + z) * DM * DM, DM, DM, wbr + (size_t)z * DM * DM, kb * 64, nb * 32, nb * 32, scr, lane); continue; } r -= I_BR;
        if (r < I_OUT) { const int kb = r / 32, nb = r % 32;
            if (waitw != nullptr) {
                for (unsigned spins = 0; spins < (1u << 22); ++spins) { if ((unsigned)__builtin_amdgcn_readfirstlane(__hip_atomic_load(waitw, __ATOMIC_RELAXED, __HIP_MEMORY_SCOPE_AGENT)) >= need) break; __builtin_amdgcn_s_sleep(2); }
                asm volatile("" ::: "memory"); }
            transpose_item(p.w_out + (size_t)l * DM * DM, DM, DM, wout, kb * 64, nb * 32, nb * 32, scr, lane); continue; } r -= I_OUT;
        { const int gn = r / 32, q = r % 32, kb = q / 8, nb8 = q % 8; const int g = gn >> 2, nb = gn & 3; const int d0 = nb8 * 32;
          const int orow = (nb * 2 + (d0 >> 7)) * 256 + g * 128 + (d0 & 127);
          transpose_item(p.gate_w + ((size_t)l * 8 + gn) * 65536, 256, 256, wg, kb * 64, d0, orow, scr, lane); }
    }
}
__device__ void ph_rms(const float* xin, const float* w, bf16_t* H, int vb, int nvb) {
    const int wave = threadIdx.x >> 6, lane = threadIdx.x & 63;
    for (int row = vb * 8 + wave; row < T_TOK; row += nvb * 8) {
        const f32x4* xr = (const f32x4*)(xin + (size_t)row * DM) + lane;
        f32x4 v[4]; float s = 0.f;
#pragma unroll
        for (int j = 0; j < 4; ++j) { v[j] = xr[64 * j]; s += (v[j][0] * v[j][0] + v[j][1] * v[j][1]) + (v[j][2] * v[j][2] + v[j][3] * v[j][3]); }
        const float rs = rsqrtf(wave_sum(s) * (1.0f / DM) + 1e-6f);
        pg8::u32x2* o8 = (pg8::u32x2*)(H + (size_t)row * DM) + lane;
#pragma unroll
        for (int j = 0; j < 4; ++j) { const f32x4 wv = ((const f32x4*)w)[lane + 64 * j]; pg8::u32x2 o; o.x = pk2(v[j][0] * rs * wv[0], v[j][1] * rs * wv[1]); o.y = pk2(v[j][2] * rs * wv[2], v[j][3] * rs * wv[3]); o8[64 * j] = o; }
    }
}
__device__ void ph_final(const Params& p, int vb, int nvb) {
    const int wave = threadIdx.x >> 6, lane = threadIdx.x & 63;
    for (int row = vb * 8 + wave; row < T_TOK; row += nvb * 8) {
        f32x4* xr = (f32x4*)(p.out + (size_t)row * DM) + lane;
        f32x4 v[4]; float s = 0.f;
#pragma unroll
        for (int j = 0; j < 4; ++j) { v[j] = xr[64 * j]; s += (v[j][0] * v[j][0] + v[j][1] * v[j][1]) + (v[j][2] * v[j][2] + v[j][3] * v[j][3]); }
        const float rs = rsqrtf(wave_sum(s) * (1.0f / DM) + 1e-6f);
#pragma unroll
        for (int j = 0; j < 4; ++j) { const f32x4 wv = ((const f32x4*)p.fnorm_w)[lane + 64 * j]; xr[64 * j] = v[j] * rs * wv; }
    }
}
__device__ void ph_rope_table(const Params& p, int vb, int nvb) {
    float2* tab = (float2*)MISC(p, OFF_ROPE);
    for (int i = vb * NT + threadIdx.x; i < SEQ * 128; i += nvb * NT) {
        const int pos = i >> 7, d = i & 127;
        const float lin = (float)d / 127.0f;
        const float invf = 1.0f / (float)pow(10000.0, (double)lin);
        const float ang = (float)pos * invf;
        double s, c; sincos((double)ang, &s, &c);
        tab[i] = make_float2((float)c, (float)s);
    }
}


__device__ __forceinline__ void ph_conv_fast(const Params& p, int l, int vb, int nvb) {
    const bf16_t* XA = REG(p, R_XA); bf16_t* CVb = REG(p, R_CVB);
    const float* cw = p.conv_w + (size_t)l * 4 * DM; const float* cb = p.conv_b + (size_t)l * DM;
    for (int it = vb * NT + threadIdx.x; it < (T_TOK / 16) * 128; it += nvb * NT) {
        const int cg8 = it & 127, tb = it >> 7; const int ch = cg8 * 8, t0 = tb * 16; const bool seq_start = (t0 & (SEQ - 1)) == 0;
        u32x4 raw[19];
#pragma unroll
        for (int j = 0; j < 19; ++j) raw[j] = (seq_start && j < 3) ? (u32x4){0u, 0u, 0u, 0u} : *(const u32x4*)(XA + (size_t)(t0 - 3 + j) * DM + ch);
        float w[4][8], bias[8];
#pragma unroll
        for (int j = 0; j < 4; ++j) { const f32x4 a = *(const f32x4*)(cw + j * DM + ch), b = *(const f32x4*)(cw + j * DM + ch + 4);
#pragma unroll
            for (int q = 0; q < 4; ++q) { w[j][q] = a[q]; w[j][4 + q] = b[q]; } }
        { const f32x4 a = *(const f32x4*)(cb + ch), b = *(const f32x4*)(cb + ch + 4);
#pragma unroll
          for (int q = 0; q < 4; ++q) { bias[q] = a[q]; bias[4 + q] = b[q]; } }
        f32x4 h[3][2];
#pragma unroll
        for (int j = 0; j < 3; ++j) unpack8(raw[j], h[j][0], h[j][1]);
#pragma unroll
        for (int t = 0; t < 16; ++t) {
            f32x4 x0, x1; unpack8(raw[3 + t], x0, x1);
            f32x4 o0, o1;
#pragma unroll
            for (int q = 0; q < 4; ++q) {
                o0[q] = bias[q] + w[0][q] * h[0][0][q] + w[1][q] * h[1][0][q] + w[2][q] * h[2][0][q] + w[3][q] * x0[q];
                o1[q] = bias[4 + q] + w[0][4 + q] * h[0][1][q] + w[1][4 + q] * h[1][1][q] + w[2][4 + q] * h[2][1][q] + w[3][4 + q] * x1[q];
            }
            wt16(CVb, CVb + (size_t)(t0 + t) * DM + ch, pack8(o0, o1));
            h[0][0] = h[1][0]; h[0][1] = h[1][1]; h[1][0] = h[2][0]; h[1][1] = h[2][1]; h[2][0] = x0; h[2][1] = x1;
        }
    }
}
__device__ __forceinline__ void lru_passA_item(const bf16_t* LA, const bf16_t* LB, float* AG, int tb, int cg8) {
    const int ch = cg8 * 8, t0 = tb * 32;
    float ls[8], hh[8];
#pragma unroll
    for (int q = 0; q < 8; ++q) { ls[q] = 0.f; hh[q] = 0.f; }
#pragma unroll 1
    for (int tq = 0; tq < 32; tq += 8) {
        u32x4 ra[8], rb[8];
#pragma unroll
        for (int t = 0; t < 8; ++t) { ra[t] = *(const u32x4*)(LA + (size_t)(t0 + tq + t) * DM + ch); rb[t] = *(const u32x4*)(LB + (size_t)(t0 + tq + t) * DM + ch); }
#pragma unroll
        for (int t = 0; t < 8; ++t) {
            f32x4 a0, a1, b0, b1; unpack8(ra[t], a0, a1); unpack8(rb[t], b0, b1);
#pragma unroll
            for (int q = 0; q < 4; ++q) { ls[q] += a0[q]; hh[q] = fexp_(a0[q]) * hh[q] + b0[q]; ls[4 + q] += a1[q]; hh[4 + q] = fexp_(a1[q]) * hh[4 + q] + b1[q]; }
        }
    }
    float* o = AG + (size_t)tb * DM + ch;
    *(f32x4*)o = (f32x4){ls[0], ls[1], ls[2], ls[3]}; *(f32x4*)(o + 4) = (f32x4){ls[4], ls[5], ls[6], ls[7]};
    float* o2 = o + (size_t)512 * DM;
    *(f32x4*)o2 = (f32x4){hh[0], hh[1], hh[2], hh[3]}; *(f32x4*)(o2 + 4) = (f32x4){hh[4], hh[5], hh[6], hh[7]};
}
__device__ void ph_lru_passA_own(const Params& p, const pg8::StaticOrder& S) {
    const bf16_t* LA = REG(p, R_LA); const bf16_t* LB = REG(p, R_LB); float* AG = (float*)MISC(p, OFF_AGG);
    Unit u;
    for (int i0 = 0; S.next(i0, u); i0 += 4) {
        const int sel = threadIdx.x >> 7, e = threadIdx.x & 127;
        if (S.next(i0 + sel, u)) lru_passA_item(LA, LB, AG, u.pm * 8 + (e >> 4), ((u.pn >> 1) * 256 + (u.pn & 1) * 128) / 8 + (e & 15));
    }
}
__device__ void ph_lru_passB(const Params& p, int vb, int nvb, LAS unsigned char* lds) {
    const float* __restrict__ AGL = (const float*)MISC(p, OFF_AGG); const float* __restrict__ AGB = AGL + (size_t)512 * DM; float* __restrict__ AGH = (float*)MISC(p, OFF_AGG) + (size_t)1024 * DM;
    LAS float* sh = (LAS float*)lds;
    for (int g = vb; g < 64; g += nvb) {
        const int chl = threadIdx.x & 31, seg = threadIdx.x >> 5; const int chain = g * 32 + chl; const int ch = chain & 1023, b = chain >> 10;
        const size_t o0 = (size_t)(b * 256 + seg * 16) * DM + ch;
        float la[16], lb[16];
#pragma unroll
        for (int i = 0; i < 16; ++i) { la[i] = AGL[o0 + (size_t)i * DM]; lb[i] = AGB[o0 + (size_t)i * DM]; }
        float LS = 0.f, HH = 0.f;
#pragma unroll
        for (int i = 0; i < 16; ++i) { LS += la[i]; HH = fexp_(la[i]) * HH + lb[i]; }
        sh[seg * 32 + chl] = LS; sh[512 + seg * 32 + chl] = HH;
        __syncthreads();
        float h = 0.f;
        for (int sgi = 0; sgi < seg; ++sgi) h = fexp_(sh[sgi * 32 + chl]) * h + sh[512 + sgi * 32 + chl];
#pragma unroll
        for (int i = 0; i < 16; ++i) { AGH[o0 + (size_t)i * DM] = h; h = fexp_(la[i]) * h + lb[i]; }
        __syncthreads();
    }
}
__device__ void ph_lru_passC(const Params& p, int vb, int nvb) {
    const bf16_t* LA = REG(p, R_LA); const bf16_t* LB = REG(p, R_LB); bf16_t* GA = REG(p, R_GA); const float* AG = (const float*)MISC(p, OFF_AGG);
    for (int it = vb * NT + threadIdx.x; it < (T_TOK / 32) * 128; it += nvb * NT) {
        const int cg8 = it & 127, tb = it >> 7; const int ch = cg8 * 8, t0 = tb * 32;
        float hh[8];
        { const float* hi = AG + (size_t)1024 * DM + (size_t)tb * DM + ch; const f32x4 a = *(const f32x4*)hi, b = *(const f32x4*)(hi + 4);
#pragma unroll
          for (int q = 0; q < 4; ++q) { hh[q] = a[q]; hh[4 + q] = b[q]; } }
#pragma unroll 1
        for (int tq = 0; tq < 32; tq += 4) {
            u32x4 ra[4], rb[4], rg[4];
#pragma unroll
            for (int t = 0; t < 4; ++t) { const size_t o = (size_t)(t0 + tq + t) * DM + ch; ra[t] = *(const u32x4*)(LA + o); rb[t] = *(const u32x4*)(LB + o); rg[t] = *(const u32x4*)(GA + o); }
#pragma unroll
            for (int t = 0; t < 4; ++t) {
                const size_t o = (size_t)(t0 + tq + t) * DM + ch;
                f32x4 a0, a1, b0, b1, g0, g1; unpack8(ra[t], a0, a1); unpack8(rb[t], b0, b1); unpack8(rg[t], g0, g1);
                f32x4 y0, y1;
#pragma unroll
                for (int q = 0; q < 4; ++q) { hh[q] = fexp_(a0[q]) * hh[q] + b0[q]; y0[q] = hh[q] * fsilu_(g0[q]); hh[4 + q] = fexp_(a1[q]) * hh[4 + q] + b1[q]; y1[q] = hh[4 + q] * fsilu_(g1[q]); }
                wt16(GA, GA + o, pack8(y0, y1));
            }
        }
    }
}


#define R_KT 5
#define R_VT 6
#define R_KV 7
#define R_PS 8
__device__ __forceinline__ float ret_log2g(int h) { return log2f(1.0f - exp2f(-5.0f - (float)h)); }
struct LoraOrder {
    int G, c;
    __device__ __forceinline__ bool next(int i, Unit& u) const { const int id = i * G + c; if (id >= 64) return false; u.pm = id; u.pn = 24; u.z = 0; return true; }
};
struct UnitOrder {
    int G, c, n;
    __device__ __forceinline__ bool next(int i, Unit& u) const { const int id = i * G + c; if (id >= n) return false; u.pm = 0; u.pn = 0; u.z = id; return true; }
};
__device__ void ph_ret_transpose(const Params& p, int vb, int nvb, LAS unsigned char* lds) {
    const int wave = __builtin_amdgcn_readfirstlane(threadIdx.x >> 6), lane = threadIdx.x & 63;
    LAS bf16_t* tl = (LAS bf16_t*)(lds + wave * 16384);
    const bf16_t* CK = REG(p, R_CK); const bf16_t* CV = REG(p, R_CV); bf16_t* KT = REG(p, R_KT); bf16_t* VT = REG(p, R_VT);
    for (int z = vb; z < 256; z += nvb)
      for (int s32 = wave; s32 < 32; s32 += 8) {
        const int sub = s32 & 15, which = s32 >> 4; const int jt = sub >> 2, dt = sub & 3, h = z & 3, bn = z >> 2;
        const bf16_t* src = (which ? CV : CK) + (size_t)(bn * 256 + jt * 64 + lane) * DM + h * 256 + dt * 64;
        const float sc = which ? 1.0f : exp2f(ret_log2g(h) * (float)(255 - (jt * 64 + lane)));
#pragma unroll
        for (int q = 0; q < 8; ++q) { f32x4 a, b; unpack8(*(const u32x4*)(src + q * 8), a, b); a = a * sc; b = b * sc; *(LAS u32x4*)(tl + lane * 72 + q * 8) = pack8(a, b); }
        asm volatile("s_waitcnt lgkmcnt(0)" ::: "memory");
        bf16_t* dst = (which ? VT : KT) + (size_t)z * 65536 + (size_t)(dt * 64 + lane) * 256 + jt * 64;
#pragma unroll
        for (int q = 0; q < 8; ++q) { u32x4 w;
            unsigned e[8];
#pragma unroll
            for (int k = 0; k < 8; ++k) e[k] = tl[(q * 8 + k) * 72 + lane];
            w.x = e[0] | (e[1] << 16); w.y = e[2] | (e[3] << 16); w.z = e[4] | (e[5] << 16); w.w = e[6] | (e[7] << 16);
            *(u32x4*)(dst + q * 8) = w; }
        asm volatile("s_waitcnt lgkmcnt(0)" ::: "memory");
      }
}
__device__ __forceinline__ void wg_self_visible() {
    asm volatile("s_waitcnt vmcnt(0)" ::: "memory"); __syncthreads();
    if (threadIdx.x == 0) { __builtin_amdgcn_fence(__ATOMIC_ACQUIRE, "agent"); asm volatile("s_waitcnt vmcnt(0)" ::: "memory"); }
    __syncthreads();
}
struct GRetKV { const char* VT; const char* KT; int K, lda, ldb;
    __device__ __forceinline__ const char* aptr(const Unit& u, int t) const { return VT + ((size_t)u.z * 65536 + (size_t)t * 64) * 2; }
    __device__ __forceinline__ const char* bptr(const Unit& u, int t) const { return KT + ((size_t)u.z * 65536 + (size_t)t * 64) * 2; } };
struct EpiKV { static constexpr bool PERM = true, AFTER_DRAIN = false; bf16_t* kv;
    __device__ __forceinline__ void operator()(const f32x4 (&acc)[2][2][4][2], const Unit& u, int wr, int wc, int fr, int fq) const {
        bf16_t* base = kv + (size_t)u.z * 65536 + (size_t)(wr * 64 + fr) * 256 + wc * 32 + 8 * fq;
#pragma unroll
        for (int ai = 0; ai < 2; ++ai)
#pragma unroll
            for (int m = 0; m < 4; ++m)
#pragma unroll
                for (int bj = 0; bj < 2; ++bj) *(u32x4*)(base + (size_t)(ai * 128 + m * 16) * 256 + bj * 128) = pack8(acc[ai][bj][m][0], acc[ai][bj][m][1]); } };
__device__ void ph_ret_scan(const Params& p, int vb, int nvb) {
    bf16_t* KV = REG(p, R_KV);
    const int lane = threadIdx.x & 63, half = lane >> 5;
    for (int it2 = vb * NT + threadIdx.x; it2 < 2 * 8 * 8192; it2 += nvb * NT) {
        const int it = (it2 >> 6) * 32 + (lane & 31);
        const int bh = it >> 13, off = (it & 8191) * 8; const int h = bh & 3, b = bh >> 2;
        const float cd = exp2f(ret_log2g(h) * 256.0f);
        bf16_t* base = KV + (size_t)((b * 32 + half * 16) * 4 + h) * 65536 + off;
        u32x4 raw[16];
#pragma unroll
        for (int i = 0; i < 16; ++i) raw[i] = *(const u32x4*)(base + (size_t)i * 4 * 65536);
        f32x4 s0 = (f32x4){0.f, 0.f, 0.f, 0.f}, s1 = s0;
#pragma unroll
        for (int i = 0; i < 16; ++i) { f32x4 a, c; unpack8(raw[i], a, c); s0 = s0 * cd + a; s1 = s1 * cd + c; }
        f32x4 c0, c1;
#pragma unroll
        for (int k = 0; k < 4; ++k) { c0[k] = __shfl(s0[k], lane & 31); c1[k] = __shfl(s1[k], lane & 31); }
        if (half == 0) { c0 = (f32x4){0.f, 0.f, 0.f, 0.f}; c1 = c0; }
        s0 = c0; s1 = c1;
#pragma unroll
        for (int i = 0; i < 16; ++i) { f32x4 a, c; unpack8(raw[i], a, c); wt16(KV, base + (size_t)i * 4 * 65536, pack8(s0, s1)); s0 = s0 * cd + a; s1 = s1 * cd + c; }
    }
}
struct GRetS { const char* Q; const char* Kk; int K, lda, ldb;
    __device__ __forceinline__ const char* aptr(const Unit& u, int t) const { return Q + ((size_t)(u.z >> 2) * 256 * 1024 + (size_t)(u.z & 3) * 256 + (size_t)t * 64) * 2; }
    __device__ __forceinline__ const char* bptr(const Unit& u, int t) const { return Kk + ((size_t)(u.z >> 2) * 256 * 1024 + (size_t)(u.z & 3) * 256 + (size_t)t * 64) * 2; } };
struct EpiScore { static constexpr bool PERM = true, AFTER_DRAIN = false; bf16_t* ps;
    __device__ __forceinline__ void operator()(const f32x4 (&acc)[2][2][4][2], const Unit& u, int wr, int wc, int fr, int fq) const {
        const int h = u.z & 3; const float l2g = ret_log2g(h);
        bf16_t* base = ps + (size_t)(u.z >> 2) * 256 * 1024 + h * 256;
        const int i0 = wr * 64 + fr, j0 = wc * 32 + 8 * fq;
        float dk[2][8];
#pragma unroll
        for (int bj = 0; bj < 2; ++bj)
#pragma unroll
            for (int k = 0; k < 8; ++k) dk[bj][k] = exp2f(-l2g * (float)(j0 + bj * 128 + k + 1));
#pragma unroll
        for (int ai = 0; ai < 2; ++ai)
#pragma unroll
            for (int m = 0; m < 4; ++m) { const int i = i0 + ai * 128 + m * 16;
#pragma unroll
                for (int bj = 0; bj < 2; ++bj) { f32x4 v0, v1;
#pragma unroll
                    for (int k = 0; k < 4; ++k) { const int j = j0 + bj * 128 + k; v0[k] = j <= i ? acc[ai][bj][m][0][k] * dk[bj][k] : 0.f; v1[k] = (j + 4) <= i ? acc[ai][bj][m][1][k] * dk[bj][4 + k] : 0.f; }
                    *(u32x4*)(base + (size_t)i * 1024 + j0 + bj * 128) = pack8(v0, v1); } } } };
struct GRetO { const char* PS; const char* Q; const char* VT; const char* SN; int K, lda, ldb;
    __device__ __forceinline__ const char* aptr(const Unit& u, int t) const { const size_t o = (size_t)(u.z >> 2) * 256 * 1024 + (size_t)(u.z & 3) * 256; return t < 4 ? PS + (o + (size_t)t * 64) * 2 : Q + (o + (size_t)(t - 4) * 64) * 2; }
    __device__ __forceinline__ const char* bptr(const Unit& u, int t) const { const size_t o = (size_t)u.z * 65536; return t < 4 ? VT + (o + (size_t)t * 64) * 2 : SN + (o + (size_t)(t - 4) * 64) * 2; } };
struct EpiRet { static constexpr bool PERM = true, AFTER_DRAIN = true; bf16_t* cg;
    __device__ __forceinline__ void fused(f32x4 (&acc)[2][2][4][2], const Unit& u, int wr, int wc, int fr, int fq, LAS unsigned char* lds, int wid, int lane) const {
        const int h = u.z & 3; const float l2g = ret_log2g(h);
        LAS float* P = (LAS float*)lds;
        float mean[2][4];
#pragma unroll
        for (int ai = 0; ai < 2; ++ai)
#pragma unroll
            for (int m = 0; m < 4; ++m) { const int i = wr * 64 + fr + ai * 128 + m * 16; const float sc = exp2f(l2g * (float)(i + 1)); float s = 0.f;
#pragma unroll
                for (int bj = 0; bj < 2; ++bj)
#pragma unroll
                    for (int n = 0; n < 2; ++n) { acc[ai][bj][m][n] = acc[ai][bj][m][n] * sc; const f32x4 x = acc[ai][bj][m][n]; s += (x[0] + x[1]) + (x[2] + x[3]); }
                s += __shfl_xor(s, 16); s += __shfl_xor(s, 32);
                if (fq == 0) P[i * 4 + wc] = s; }
        asm volatile("s_waitcnt lgkmcnt(0)" ::: "memory"); __builtin_amdgcn_s_barrier(); asm volatile("" ::: "memory");
#pragma unroll
        for (int ai = 0; ai < 2; ++ai)
#pragma unroll
            for (int m = 0; m < 4; ++m) { const int i = wr * 64 + fr + ai * 128 + m * 16; const f32x4 q = *(const LAS f32x4*)(P + i * 4); mean[ai][m] = ((q[0] + q[1]) + (q[2] + q[3])) * (1.0f / 256.0f); }
        asm volatile("s_waitcnt lgkmcnt(0)" ::: "memory"); __builtin_amdgcn_s_barrier(); asm volatile("" ::: "memory");
#pragma unroll
        for (int ai = 0; ai < 2; ++ai)
#pragma unroll
            for (int m = 0; m < 4; ++m) { const int i = wr * 64 + fr + ai * 128 + m * 16; float s = 0.f;
#pragma unroll
                for (int bj = 0; bj < 2; ++bj)
#pragma unroll
                    for (int n = 0; n < 2; ++n) { const f32x4 d = acc[ai][bj][m][n] - mean[ai][m]; s += (d[0] * d[0] + d[1] * d[1]) + (d[2] * d[2] + d[3] * d[3]); }
                s += __shfl_xor(s, 16); s += __shfl_xor(s, 32);
                if (fq == 0) P[i * 4 + wc] = s; }
        asm volatile("s_waitcnt lgkmcnt(0)" ::: "memory"); __builtin_amdgcn_s_barrier(); asm volatile("" ::: "memory");
        bf16_t* base = cg + (size_t)(u.z >> 2) * 256 * 1024 + h * 256 + wc * 32 + 8 * fq;
#pragma unroll
        for (int ai = 0; ai < 2; ++ai)
#pragma unroll
            for (int m = 0; m < 4; ++m) { const int i = wr * 64 + fr + ai * 128 + m * 16; const f32x4 q = *(const LAS f32x4*)(P + i * 4);
                const float rstd = rsqrtf(((q[0] + q[1]) + (q[2] + q[3])) * (1.0f / 256.0f) + 1e-5f);
#pragma unroll
                for (int bj = 0; bj < 2; ++bj) { bf16_t* gp = base + (size_t)i * 1024 + bj * 128; f32x4 g0, g1; unpack8(*(const u32x4*)gp, g0, g1); f32x4 y0, y1;
#pragma unroll
                    for (int k = 0; k < 4; ++k) { y0[k] = (acc[ai][bj][m][0][k] - mean[ai][m]) * rstd * fsilu_(g0[k]); y1[k] = (acc[ai][bj][m][1][k] - mean[ai][m]) * rstd * fsilu_(g1[k]); }
                    *(u32x4*)gp = pack8(y0, y1); } }
        asm volatile("s_waitcnt lgkmcnt(0)" ::: "memory"); __builtin_amdgcn_s_barrier(); asm volatile("" ::: "memory");
    }
};
__device__ __forceinline__ void ph_ret_out_fast(const Params& p, int vb, int nvb, LAS unsigned char* lds) {
    UnitOrder S{nvb, vb, 256};
    { GRetS g{(const char*)REG(p, R_CQ), (const char*)REG(p, R_CK), 256, DM, DM}; EpiScore e{REG(p, R_PS)};
      pg8::gemm_phase<GRetS, EpiScore, UnitOrder, true, true>(lds, g, S, e); }
    asm volatile("s_waitcnt vmcnt(0)" ::: "memory"); __syncthreads();
    if (threadIdx.x == 0) { __builtin_amdgcn_fence(__ATOMIC_ACQUIRE, "agent"); asm volatile("s_waitcnt vmcnt(0)" ::: "memory"); }
    __syncthreads();
    { GRetO g{(const char*)REG(p, R_PS), (const char*)REG(p, R_CQ), (const char*)REG(p, R_VT), (const char*)REG(p, R_KV), 512, DM, 256}; EpiRet e{REG(p, R_CG)};
      pg8::gemm_phase<GRetO, EpiRet, UnitOrder, true, true>(lds, g, S, e); }
}

__device__ __forceinline__ float ret_logg(int h) { return (float)log1p(-exp2(-5.0 - (double)h)); }
__device__ void ph_ret_scores(const Params& p, int vb, int nvb) {
    const bf16_t* Q = REG(p, R_CQ); const bf16_t* Kb = REG(p, R_CK); float* SC = (float*)REG(p, R_SC);
    const size_t n = (size_t)512 * 128 * 128;
    for (size_t idx = (size_t)vb * NT + threadIdx.x; idx < n; idx += (size_t)nvb * NT) {
        const int j = (int)(idx & 127), i = (int)((idx >> 7) & 127); const int u = (int)(idx >> 14);
        const int h = u & 3, bn = u >> 2;
        float v = 0.f;
        if (j <= i) {
            const bf16_t* qp = Q + (size_t)(bn * 128 + i) * DM + h * 256; const bf16_t* kp = Kb + (size_t)(bn * 128 + j) * DM + h * 256;
            float s = 0.f;
            for (int d = 0; d < 256; ++d) s += bf2f(qp[d]) * bf2f(kp[d]);
            v = s * expf(ret_logg(h) * (float)(i - j));
        }
        SC[idx] = v;
    }
}
__device__ void ph_ret_states(const Params& p, int vb, int nvb) {
    const bf16_t* Kb = REG(p, R_CK); const bf16_t* V = REG(p, R_CV); bf16_t* SN = REG(p, R_SN);
    const int n = 8 * 256 * 256;
    for (int idx = vb * NT + threadIdx.x; idx < n; idx += nvb * NT) {
        const int e = idx & 255, d = (idx >> 8) & 255, bh = idx >> 16; const int h = bh & 3, b = bh >> 2;
        const float lg = ret_logg(h); const float cd = expf(lg * 128.0f);
        float st = 0.f;
        for (int c = 0; c < 64; ++c) {
            SN[((size_t)((b * 64 + c) * 4 + h) * 256 + d) * 256 + e] = f2bf(st);
            float acc = 0.f;
            const size_t t0 = (size_t)b * SEQ + c * 128;
            for (int j = 0; j < 128; ++j) acc += bf2f(Kb[(t0 + j) * DM + h * 256 + d]) * expf(lg * (float)(127 - j)) * bf2f(V[(t0 + j) * DM + h * 256 + e]);
            st = st * cd + acc;
        }
    }
}
__device__ void ph_ret_out(const Params& p, int vb, int nvb, LAS float* red) {
    const bf16_t* Q = REG(p, R_CQ); const bf16_t* V = REG(p, R_CV); const bf16_t* SN = REG(p, R_SN); const float* SC = (const float*)REG(p, R_SC);
    bf16_t* G = REG(p, R_CG);
    const int e = threadIdx.x & 255, half = threadIdx.x >> 8;
    for (int it = vb; it < T_TOK * 2; it += nvb) {
        const int u = it * 2 + half;
        const int h = u & 3, t = u >> 2; const int i = t & 127, bn = t >> 7;
        const float* sc = SC + ((size_t)(bn * 4 + h) * 128 + i) * 128;
        float o = 0.f;
        for (int j = 0; j <= i; ++j) o += sc[j] * bf2f(V[(size_t)(bn * 128 + j) * DM + h * 256 + e]);
        const float qd = expf(ret_logg(h) * (float)(i + 1));
        const bf16_t* qp = Q + (size_t)t * DM + h * 256; const bf16_t* sn = SN + (size_t)(bn * 4 + h) * 65536 + e;
        float cr = 0.f;
        for (int d = 0; d < 256; ++d) cr += bf2f(qp[d]) * bf2f(sn[(size_t)d * 256]);
        o += cr * qd;
        const float mean = half_sum(o, red) * (1.0f / 256.0f);
        const float dv = o - mean;
        const float var = half_sum(dv * dv, red) * (1.0f / 256.0f);
        const float y = dv * rsqrtf(var + 1e-5f);
        const size_t gi = (size_t)t * DM + h * 256 + e;
        G[gi] = f2bf(y * siluf_(bf2f(G[gi])));
    }
}
__device__ void ph_conv(const Params& p, int l, int vb, int nvb) {
    const bf16_t* XA = REG(p, R_XA); bf16_t* CVb = REG(p, R_CVB);
    const float* cw = p.conv_w + (size_t)l * 4 * DM; const float* cb = p.conv_b + (size_t)l * DM;
    const size_t n = (size_t)T_TOK * DM;
    for (size_t idx = (size_t)vb * NT + threadIdx.x; idx < n; idx += (size_t)nvb * NT) {
        const int ch = (int)(idx & 1023); const int t = (int)(idx >> 10); const int s = t & (SEQ - 1);
        float acc = cb[ch];
#pragma unroll
        for (int j = 0; j < 4; ++j) { const int ss = s - 3 + j; if (ss >= 0) acc += cw[j * DM + ch] * bf2f(XA[(size_t)(t - 3 + j) * DM + ch]); }
        CVb[idx] = f2bf(acc);
    }
}
__device__ void ph_lru_scan(const Params& p, int vb, int nvb) {
    const bf16_t* LA = REG(p, R_LA); const bf16_t* LB = REG(p, R_LB); bf16_t* GA = REG(p, R_GA);
    for (int idx = vb * NT + threadIdx.x; idx < 2 * DM; idx += nvb * NT) {
        const int ch = idx & 1023, b = idx >> 10;
        float h = 0.f;
        for (int s = 0; s < SEQ; ++s) {
            const size_t i = ((size_t)b * SEQ + s) * DM + ch;
            h = expf(bf2f(LA[i])) * h + bf2f(LB[i]);
            GA[i] = f2bf(h * siluf_(bf2f(GA[i])));
        }
    }
}
__device__ void ph_rwkv_prep(const Params& p, int l, int vb, int nvb) {
    const bf16_t* BL = (const bf16_t*)MISC(p, OFF_BL); bf16_t* LD = REG(p, R_LD); bf16_t* AA = REG(p, R_AA);
    const float* mu = p.mu + (size_t)l * 4224 + 4096; const float* w2 = p.w2 + (size_t)l * 64 * DM; const float* a2 = p.a2 + (size_t)l * 64 * DM;
    const float* w0 = p.w0 + (size_t)l * DM; const float* a0 = p.a0 + (size_t)l * DM;
    const size_t n = (size_t)T_TOK * DM;
    for (size_t idx = (size_t)vb * NT + threadIdx.x; idx < n; idx += (size_t)nvb * NT) {
        const int ch = (int)(idx & 1023); const int t = (int)(idx >> 10); const bool first = (t & (SEQ - 1)) == 0;
        const bf16_t* cur = BL + (size_t)t * 128; const bf16_t* prv = cur - 128;
        float dw = 0.f, da = 0.f;
        for (int j = 0; j < 64; ++j) {
            const float c0 = bf2f(cur[j]), p0 = first ? 0.f : bf2f(prv[j]);
            const float c1 = bf2f(cur[64 + j]), p1 = first ? 0.f : bf2f(prv[64 + j]);
            const float wl = c0 + (p0 - c0) * mu[j], al = c1 + (p1 - c1) * mu[64 + j];
            dw += tanhf(wl) * w2[(size_t)j * DM + ch]; da += al * a2[(size_t)j * DM + ch];
        }
        const float w_log = -softplusf_(-(w0[ch] + dw)) - 0.5f;
        LD[idx] = f2bf(-expf(w_log));
        AA[idx] = f2bf(sigmoidf_(a0[ch] + da));
    }
}
__device__ void ph_rwkv_rec(const Params& p, int l, int vb, int nvb, LAS float* smem) {
    const int wave = threadIdx.x >> 6, lane = threadIdx.x & 63, pr_ = wave >> 1, hw = wave & 1;
    LAS float* sh = smem + pr_ * 8 * 64;
    const bf16_t* BR = REG(p, R_BR); const bf16_t* BK = REG(p, R_BK); const bf16_t* BV = REG(p, R_BV); bf16_t* BG = REG(p, R_BG);
    const bf16_t* LD = REG(p, R_LD); const bf16_t* AA = REG(p, R_AA);
    for (int ub = vb; ub < 8; ub += nvb) {
        const int unit = ub * 4 + pr_; const int h = unit & 15, b = unit >> 4; const int ch = h * 64 + lane;
        const float* mu = p.mu + (size_t)l * 4224;
        const float mu_r = mu[ch], mu_k = mu[DM + ch], mu_v = mu[2 * DM + ch], mu_g = mu[3 * DM + ch];
        const float kk_w = p.k_k[(size_t)l * DM + ch], ka_w = p.k_a[(size_t)l * DM + ch], rk_w = p.r_k[(size_t)l * DM + ch];
        const float ln_w = p.lnx_w[(size_t)l * DM + ch], ln_b = p.lnx_b[(size_t)l * DM + ch];
        const int row = hw * 32 + (lane >> 1), kh0 = (lane & 1) * 32;
        float st[32];
#pragma unroll
        for (int k = 0; k < 32; ++k) st[k] = 0.f;
        float pr = 0.f, pk = 0.f, pv = 0.f, pg = 0.f;
        for (int s = 0; s < SEQ; ++s) {
            const size_t i = ((size_t)b * SEQ + s) * DM + ch;
            const float cr = bf2f(BR[i]), ck = bf2f(BK[i]), cv = bf2f(BV[i]), cgv = bf2f(BG[i]);
            const float r = cr + (pr - cr) * mu_r, k = ck + (pk - ck) * mu_k, v = cv + (pv - cv) * mu_v, g = cgv + (pg - cgv) * mu_g;
            pr = cr; pk = ck; pv = cv; pg = cgv;
            const float w = expf(bf2f(LD[i])), a = bf2f(AA[i]);
            const float kkc = k * kk_w;
            const float nrm = sqrtf(wave_sum(kkc * kkc));
            const float kk = kkc / fmaxf(nrm, 1e-12f);
            const float kh = k * (1.0f + (a - 1.0f) * ka_w);
            const float bonus_s = wave_sum(r * kh * rk_w);
            __syncthreads();
            if (hw == 0) { sh[lane] = r; sh[64 + lane] = w; sh[128 + lane] = kh; sh[192 + lane] = kk; sh[256 + lane] = kk * a; sh[320 + lane] = v; }
            __syncthreads();
            const float vr = sh[320 + row];
            float sa = 0.f;
#pragma unroll
            for (int kx = 0; kx < 32; ++kx) sa -= st[kx] * sh[192 + kh0 + kx];
            sa += __shfl_xor(sa, 1);
            float y = 0.f;
#pragma unroll
            for (int kx = 0; kx < 32; ++kx) { st[kx] = st[kx] * sh[64 + kh0 + kx] + sa * sh[256 + kh0 + kx] + vr * sh[128 + kh0 + kx]; y += st[kx] * sh[kh0 + kx]; }
            y += __shfl_xor(y, 1);
            if ((lane & 1) == 0) sh[384 + row] = y;
            __syncthreads();
            const float yc = sh[384 + lane];
            const float mean = wave_sum(yc) * (1.0f / 64.0f);
            const float dv = yc - mean;
            const float var = wave_sum(dv * dv) * (1.0f / 64.0f);
            const float yn = dv * rsqrtf(var + 64e-5f) * ln_w + ln_b;
            if (hw == 0) BG[i] = f2bf((yn + bonus_s * v) * siluf_(g));
        }
    }
}


#if defined(DEBUG_CHECK)
#define OFF_CK ((OFF_END + 255ull) & ~255ull)
__device__ __forceinline__ unsigned hash_u(unsigned x) { x ^= x >> 16; x *= 0x7feb352dU; x ^= x >> 15; x *= 0x846ca68bU; x ^= x >> 16; return x; }
__device__ __forceinline__ void ck_add(float* slot, float e2, float r2) {
    e2 = wave_sum(e2); r2 = wave_sum(r2);
    if ((threadIdx.x & 63) == 0) { atomicAdd(slot, e2); atomicAdd(slot + 1, r2); }
}
__device__ __forceinline__ float dot_bf_f32(const bf16_t* a, const float* w, int ldw, int K) { float s = 0.f; for (int k = 0; k < K; ++k) s += bf2f(a[k]) * w[(size_t)k * ldw]; return s; }
__device__ __forceinline__ void check_phase(const Params& p, int l, int ph, int vb, int nvb) {
    if (vb >= 32) return;
    float* slot = (float*)MISC(p, OFF_CK) + (l * 16 + ph) * 2;
    const unsigned sid = (unsigned)(vb * NT + threadIdx.x);
    const unsigned h1 = hash_u(sid * 2654435761u + 12345u + (unsigned)(l * 16 + ph)), h2 = hash_u(h1 + 0x9e3779b9u);
    const int r = (int)(h1 & 16383);
    const float* win = p.w_in + (size_t)l * DM * NIN;
    const bf16_t* H = REG(p, R_H) + (size_t)r * DM;
    float e2 = 0.f, r2 = 0.f;
    switch (ph) {
    case 0: {
        const int c = (int)(h2 & 1023); const float* xin = l == 0 ? p.x : p.out;
        float ss = 0.f; for (int k = 0; k < DM; ++k) { const float v = xin[(size_t)r * DM + k]; ss += v * v; }
        const float ref = bf2f(f2bf(xin[(size_t)r * DM + c] * rsqrtf(ss * (1.0f / DM) + 1e-6f) * p.norm_w[(size_t)l * DM + c]));
        const float got = bf2f(H[c]); e2 += (got - ref) * (got - ref); r2 += ref * ref;
        const int n = (int)(h2 % NIN), k = (int)((h2 >> 16) & 1023);
        const float wr = bf2f(f2bf(win[(size_t)k * NIN + n])), wg = bf2f(((const bf16_t*)MISC(p, OFF_WIN))[(size_t)n * DM + k]);
        e2 += (wr - wg) * (wr - wg); r2 += wr * wr;
        const int z = (int)(h2 % 3), n2 = (int)((h2 >> 8) & 1023);
        const float br = bf2f(f2bf(p.w_branch[((size_t)l * 3 + z) * DM * DM + (size_t)k * DM + n2])), bg = bf2f(((const bf16_t*)MISC(p, OFF_WBR))[((size_t)z * DM + n2) * DM + k]);
        e2 += (br - bg) * (br - bg); r2 += br * br;
        const float orf = bf2f(f2bf(p.w_out[(size_t)l * DM * DM + (size_t)k * DM + n2])), og = bf2f(((const bf16_t*)MISC(p, OFF_WOUT))[(size_t)n2 * DM + k]);
        e2 += (orf - og) * (orf - og); r2 += orf * orf;
    } break;
    case 1: {
        const int which = (int)(h2 & 3), head = (int)((h2 >> 2) & 3), d = (int)((h2 >> 4) & 127);
        const int cl = head * 256 + d, chh = cl + 128;
        float lo = dot_bf_f32(H, win + 6272 + which * 1024 + cl, NIN, DM), hi = dot_bf_f32(H, win + 6272 + which * 1024 + chh, NIN, DM);
        if (which < 2) { const float2 cs = ((const float2*)MISC(p, OFF_ROPE))[(size_t)(r & (SEQ - 1)) * 128 + d]; const float a = lo * cs.x - hi * cs.y, b = lo * cs.y + hi * cs.x; const float sc = which == 1 ? 0.0625f : 1.f; lo = a * sc; hi = b * sc; }
        const bf16_t* o = REG(p, R_CQ + which) + (size_t)r * DM;
        const float g0 = bf2f(o[cl]), g1 = bf2f(o[chh]);
        e2 += (g0 - lo) * (g0 - lo) + (g1 - hi) * (g1 - hi); r2 += lo * lo + hi * hi;
    } break;
    case 5: {
        const int g = (int)(h2 % 6), c = (int)((h2 >> 8) & 1023); const int rg = 1 + g + (g >= 3 ? 1 : 0);
        const float ref = dot_bf_f32(H, win + g * 1024 + c, NIN, DM); const float got = bf2f(REG(p, rg)[(size_t)r * DM + c]);
        e2 += (got - ref) * (got - ref); r2 += ref * ref;
        const int c2 = (int)((h2 >> 20) & 127);
        const float ref2 = dot_bf_f32(H, win + 6144 + c2, NIN, DM); const float got2 = bf2f(((const bf16_t*)MISC(p, OFF_BL))[(size_t)r * 128 + c2]);
        e2 += (got2 - ref2) * (got2 - ref2); r2 += ref2 * ref2;
    } break;
    case 7: {
        const int ch = (int)(h2 & 1023), nb = ch >> 8, d = ch & 255;
        const bf16_t* cp = REG(p, R_CVB) + (size_t)r * DM + nb * 256;
        const float* gw = p.gate_w + (size_t)l * 8 * 65536;
        float g0 = p.gate_b[(size_t)l * 2 * DM + ch], g1 = p.gate_b[(size_t)l * 2 * DM + DM + ch];
        for (int c = 0; c < 256; ++c) { const float cv = bf2f(cp[c]); g0 += cv * gw[((size_t)(0 * 4 + nb) * 256 + c) * 256 + d]; g1 += cv * gw[((size_t)(1 * 4 + nb) * 256 + c) * 256 + d]; }
        const float log_a = -8.0f * sigmoidf_(g0) * softplusf_(-p.lam[(size_t)l * DM + ch]);
        float mult = sqrtf(fmaxf(-expm1f(2.0f * log_a), 0.f)); if ((r & (SEQ - 1)) == 0) mult = 1.0f;
        const float bb = mult * sigmoidf_(g1) * bf2f(cp[d]);
        const float ga = bf2f(REG(p, R_LA)[(size_t)r * DM + ch]), gbb = bf2f(REG(p, R_LB)[(size_t)r * DM + ch]);
        e2 += (ga - log_a) * (ga - log_a) * 1e4f + (gbb - bb) * (gbb - bb); r2 += log_a * log_a * 1e4f + bb * bb;
    } break;
    case 13: {
        const int c = (int)(h2 % 3072);
        const float ref = sigmoidf_(dot_bf_f32(H, win + 10368 + c, NIN, DM) + p.b_merge[(size_t)l * 3072 + c]);
        const float got = bf2f(REG(p, R_PM)[(size_t)(c >> 10) * (UNIT / 2) + (size_t)r * DM + (c & 1023)]);
        e2 += (got - ref) * (got - ref); r2 += ref * ref;

    } break;
    case 14: {
        const int c = (int)(h2 & 1023); float ref = 0.f;
        for (int z = 0; z < 3; ++z) { const bf16_t* y = (z == 0 ? REG(p, R_GA) : (z == 1 ? REG(p, R_BG) : REG(p, R_CG))) + (size_t)r * DM;
            ref += bf2f(REG(p, R_PM)[(size_t)z * (UNIT / 2) + (size_t)r * DM + c]) * dot_bf_f32(y, p.w_branch + ((size_t)l * 3 + z) * DM * DM + c, DM, DM); }
        const float got = bf2f(REG(p, R_MG)[(size_t)r * DM + c]);
        e2 += (got - ref) * (got - ref); r2 += ref * ref;
    } break;
    case 15: if (l == 0) {
        const int c = (int)(h2 & 1023);
        const float ref = p.x[(size_t)r * DM + c] + dot_bf_f32(REG(p, R_MG) + (size_t)r * DM, p.w_out + (size_t)l * DM * DM + c, DM, DM);
        const float got = p.out[(size_t)r * DM + c];
        e2 += (got - ref) * (got - ref); r2 += ref * ref;
    } break;
    default: break;
    }
    ck_add(slot, e2, r2);
}
__device__ int ck_bucket(const float* ck, int idx) { const float e = ck[idx * 2], r = ck[idx * 2 + 1]; if (!(r > 0.f)) return 9; int b = (int)(-2.0f * log10f(fmaxf(sqrtf(e / r), 1e-9f)) + 0.5f); return b > 9 ? 9 : (b < 0 ? 0 : b); }
__global__ void k_report(Params p) {
    const float* ck = (const float*)MISC(p, OFF_CK);
    int code = 0; float mx = 0.f;
    for (int g = 0; g < 32; ++g) { const float e = ck[g * 2], r = ck[g * 2 + 1]; if (r > 0.f) { const float rel = sqrtf(e / r); if (rel > mx) mx = rel; if (!code && rel > 0.02f) code = g + 1; } }
    float val;
    if (code) val = 100.0f * (float)code; else { int b = (int)(-2.0f * log10f(fmaxf(mx, 1e-9f)) + 0.5f); if (b > 9) b = 9; if (b < 0) b = 0; val = 100.0f * (float)(40 + b); }
    for (size_t i = (size_t)blockIdx.x * blockDim.x + threadIdx.x; i < (size_t)T_TOK * DM; i += (size_t)gridDim.x * blockDim.x) p.out[i] = val;
}
#endif

#ifndef R_WM
#define R_WM 1
#define R_WN 8
#define R_WQ 9
#define R_WY 10
#define R_WH 3
#define R_YB 5
#endif
typedef short bf16x8_t __attribute__((ext_vector_type(8)));
__device__ __forceinline__ int swz(int row, int col) { const int f = (row & 2) | ((row >> 2) & 1) | ((((row >> 3) ^ (row >> 2)) & 1) << 2); return row * 128 + ((((col >> 3) ^ f) << 4) | ((col & 7) << 1)); }
#define RW_MAT(i) (lds + (i) * 8192)
__device__ __forceinline__ f32x4 mm16(const LAS unsigned char* A, const LAS unsigned char* Bt, int rt, int ct, f32x4 acc, int lane) {
    const int r = lane & 15, kg = lane >> 4;
#pragma unroll
    for (int ks = 0; ks < 2; ++ks) {
        const bf16x8_t a = *(const LAS bf16x8_t*)(A + swz(16 * rt + r, ks * 32 + kg * 8)), b = *(const LAS bf16x8_t*)(Bt + swz(16 * ct + r, ks * 32 + kg * 8));
        acc = __builtin_amdgcn_mfma_f32_16x16x32_bf16(a, b, acc, 0, 0, 0);
    }
    return acc;
}
__device__ __forceinline__ f32x4 mm16s(const LAS unsigned char* A, const LAS unsigned char* Bt, int rt, int ct, f32x4 acc, int lane) {
    const int r = lane & 15, kg = lane >> 4;
#pragma unroll
    for (int ks = 0; ks < 2; ++ks) {
        const bf16x8_t a = *(const LAS bf16x8_t*)(A + swz(16 * rt + r, ks * 32 + kg * 8)), b = *(const LAS bf16x8_t*)(Bt + swz(16 * ct + r, ks * 32 + kg * 8));
        acc = __builtin_amdgcn_mfma_f32_16x16x32_bf16(b, a, acc, 0, 0, 0);
    }
    return acc;
}
__device__ __forceinline__ void st_rowmajor(LAS unsigned char* C, int rt, int ct, const f32x4& v, int lane) {
    const int row = 16 * rt + 4 * (lane >> 4), col = 16 * ct + (lane & 15);
#pragma unroll
    for (int q = 0; q < 4; ++q) *(LAS bf16_t*)(C + swz(row + q, col)) = f2bf(v[q]);
}
__device__ __forceinline__ void st_transposed(LAS unsigned char* Ct, int rt, int ct, const f32x4& v, int lane) {
    const int row = 16 * rt + 4 * (lane >> 4), col = 16 * ct + (lane & 15);
    pg8::u32x2 w; w.x = pg8::cvt_pk_bf16(v[0], v[1]); w.y = pg8::cvt_pk_bf16(v[2], v[3]);
    *(LAS pg8::u32x2*)(Ct + swz(col, row)) = w;
}
__device__ __forceinline__ void st_rowmajor_s(LAS unsigned char* C, int rt, int ct, const f32x4& v, int lane) {
    const int row = 16 * rt + (lane & 15), col = 16 * ct + 4 * (lane >> 4);
    pg8::u32x2 w; w.x = pg8::cvt_pk_bf16(v[0], v[1]); w.y = pg8::cvt_pk_bf16(v[2], v[3]);
    *(LAS pg8::u32x2*)(C + swz(row, col)) = w;
}
struct RwFrag { bf16x8_t k[2]; };
__device__ __forceinline__ RwFrag rw_ldfrag(const LAS unsigned char* M, int r0, int lane) { RwFrag f; const int r = lane & 15, kg = lane >> 4;
    f.k[0] = *(const LAS bf16x8_t*)(M + swz(r0 + r, kg * 8)); f.k[1] = *(const LAS bf16x8_t*)(M + swz(r0 + r, 32 + kg * 8)); return f; }
typedef short s16x4_t __attribute__((ext_vector_type(4)));
typedef short s16x8_t __attribute__((ext_vector_type(8)));
__device__ __forceinline__ RwFrag rw_ldfrag_tr(const LAS unsigned char* M, int c0, int lane) { RwFrag f; const int g = lane >> 4, q = (lane & 15) >> 2, p = lane & 3;
#pragma unroll
    for (int ks = 0; ks < 2; ++ks) {
        const s16x4_t lo = __builtin_amdgcn_ds_read_tr16_b64_v4i16((LAS s16x4_t*)(M + swz(32 * ks + 8 * g + q, c0 + 4 * p)));
        const s16x4_t hi = __builtin_amdgcn_ds_read_tr16_b64_v4i16((LAS s16x4_t*)(M + swz(32 * ks + 8 * g + 4 + q, c0 + 4 * p)));
        const s16x8_t v = {lo[0], lo[1], lo[2], lo[3], hi[0], hi[1], hi[2], hi[3]};
        f.k[ks] = __builtin_bit_cast(bf16x8_t, v);
    }
    return f; }
__device__ __forceinline__ f32x4 rw_mma(const RwFrag& x, const RwFrag& y, f32x4 acc) {
    acc = __builtin_amdgcn_mfma_f32_16x16x32_bf16(x.k[0], y.k[0], acc, 0, 0, 0); return __builtin_amdgcn_mfma_f32_16x16x32_bf16(x.k[1], y.k[1], acc, 0, 0, 0); }
#define RW_BAR() do { asm volatile("s_waitcnt lgkmcnt(0)" ::: "memory"); __builtin_amdgcn_s_barrier(); asm volatile("" ::: "memory"); } while (0)

__device__ __forceinline__ int fragA_idx(int i, int k) { const int rtile = i >> 5, r = i & 31, s = k >> 4, w = k & 15; const int a = (w >> 3) & 1, hh = (w >> 2) & 1, b = w & 3; return (((rtile * 4 + s) * 64 + r + 32 * hh) * 8) + 4 * a + b; }
__device__ __forceinline__ int accG_idx(int i, int v) { const int ct = v >> 5, c = v & 31, rtile = i >> 5, rr = i & 31; const int hh = (rr >> 2) & 1, reg = (rr & 3) + 4 * (rr >> 3); return ((ct * 2 + rtile) * 64 + c + 32 * hh) * 16 + reg; }

__device__ __forceinline__ f32x4 mm16g(const LAS unsigned char* A, const bf16_t* Btg, int rt, int ct, f32x4 acc, int lane) {
    const int r = lane & 15, kg = lane >> 4;
#pragma unroll
    for (int ks = 0; ks < 2; ++ks) {
        const bf16x8_t a = *(const LAS bf16x8_t*)(A + swz(16 * rt + r, ks * 32 + kg * 8)), b = *(const bf16x8_t*)(Btg + (size_t)(16 * ct + r) * 64 + ks * 32 + kg * 8);
        acc = __builtin_amdgcn_mfma_f32_16x16x32_bf16(a, b, acc, 0, 0, 0);
    }
    return acc;
}
__device__ void ph_rwkv_pre(const Params& p, int l, int vb, int nvb, LAS unsigned char* lds) {
    const int tid = threadIdx.x, wave = __builtin_amdgcn_readfirstlane(tid >> 6), lane = tid & 63;
    const bf16_t* BR = REG(p, R_BR); const bf16_t* BK = REG(p, R_BK); const bf16_t* BV = REG(p, R_BV); const bf16_t* BL = (const bf16_t*)MISC(p, OFF_BL);
    bf16_t* WM = REG(p, R_WM); bf16_t* WN = REG(p, R_WN); bf16_t* WQ = REG(p, R_WQ); bf16_t* WY = REG(p, R_WY);
    float* GC = (float*)MISC(p, OFF_GC); float* BON = (float*)MISC(p, OFF_BON);
    const bf16_t* W2T = (const bf16_t*)MISC(p, OFF_W2T); const bf16_t* A2T = (const bf16_t*)MISC(p, OFF_A2T);
    const float* mu = p.mu + (size_t)l * 4224;
    LAS unsigned char* AL = RW_MAT(0); LAS unsigned char* ALt = RW_MAT(1); LAS unsigned char* BE = RW_MAT(2); LAS unsigned char* KT = RW_MAT(3);
    LAS unsigned char* RT = RW_MAT(4); LAS unsigned char* BHt = RW_MAT(5); LAS unsigned char* KCt = RW_MAT(6); LAS unsigned char* VVt = RW_MAT(7);
    LAS unsigned char* AAB = RW_MAT(8); LAS unsigned char* PT0 = RW_MAT(9); LAS unsigned char* AAK = RW_MAT(10); LAS unsigned char* ARB = RW_MAT(11);
    LAS unsigned char* ARK = RW_MAT(12); LAS unsigned char* TMa = RW_MAT(13); LAS unsigned char* XT = RW_MAT(14); LAS unsigned char* W2t = RW_MAT(15);
    LAS unsigned char* TWm = RW_MAT(16); LAS unsigned char* TAm = RW_MAT(17); LAS unsigned char* VVr = RW_MAT(18);
    LAS unsigned char* BHr = RW_MAT(5); LAS unsigned char* KCr = RW_MAT(6);
    LAS unsigned char* TMb = KT; LAS unsigned char* W1t = AAK;
    LAS unsigned char* W2S = RW_MAT(1); LAS unsigned char* A2S = RW_MAT(7);
    LAS float* FW = (LAS float*)RW_MAT(8); LAS float* FA = (LAS float*)RW_MAT(10); LAS float* CUM = (LAS float*)RW_MAT(12);
    LAS float* TT = (LAS float*)(lds + RW_LDS_MISC + 128);
    const int rt_w = wave >> 1, ct0 = (wave & 1) * 2;
    for (int bc = vb; bc < 256; bc += nvb) {
        const int t0 = bc * 64; const bool first = (t0 & (SEQ - 1)) == 0;
        for (int e = tid; e < 64 * 16; e += NT) {
            const int t = e >> 4, grp = e & 15;
            f32x4 c0, c1, p0, p1; unpack8(*(const u32x4*)(BL + (size_t)(t0 + t) * 128 + grp * 8), c0, c1);
            if (first && t == 0) { p0 = (f32x4){0.f, 0.f, 0.f, 0.f}; p1 = p0; } else unpack8(*(const u32x4*)(BL + (size_t)(t0 + t - 1) * 128 + grp * 8), p0, p1);
            const f32x4 m0 = *(const f32x4*)(mu + 4096 + grp * 8), m1 = *(const f32x4*)(mu + 4096 + grp * 8 + 4);
            f32x4 x0 = c0 + (p0 - c0) * m0, x1 = c1 + (p1 - c1) * m1;
            if (grp < 8) {
#pragma unroll
                for (int q = 0; q < 4; ++q) { const float e0 = fexp_(2.0f * x0[q]), e1 = fexp_(2.0f * x1[q]); x0[q] = 1.0f - 2.0f * __builtin_amdgcn_rcpf(e0 + 1.0f); x1[q] = 1.0f - 2.0f * __builtin_amdgcn_rcpf(e1 + 1.0f); }
                *(LAS u32x4*)(TWm + swz(t, grp * 8)) = pack8(x0, x1);
            } else *(LAS u32x4*)(TAm + swz(t, (grp - 8) * 8)) = pack8(x0, x1);
        }
        LAS float* WA = (LAS float*)(lds + RW_LDS_MISC + 1280);
#define RWP_WA_SRC(HH) ((((tid - 96) >> 4) ? p.a0 : p.w0) + (size_t)l * DM + (HH) * 64 + ((tid - 96) & 15) * 4)
#define RWP_WA_DST(HH) (WA + ((HH) & 1) * 128 + ((tid - 96) >> 4) * 64 + ((tid - 96) & 15) * 4)
        if (tid >= 96 && tid < 128) *(LAS f32x4*)RWP_WA_DST(0) = *(const f32x4*)RWP_WA_SRC(0);
        const int ls_row = tid >> 3, ls_col = (tid & 7) * 8;
        *(LAS u32x4*)(W2S + swz(ls_row, ls_col)) = *(const u32x4*)(W2T + (size_t)ls_row * 64 + ls_col);
        *(LAS u32x4*)(A2S + swz(ls_row, ls_col)) = *(const u32x4*)(A2T + (size_t)ls_row * 64 + ls_col);
        RW_BAR();
#define RWP_PRM_SRC(HH) (pa_ == 0 ? mu + (HH) * 64 : pa_ == 1 ? mu + DM + (HH) * 64 : pa_ == 2 ? mu + 2 * DM + (HH) * 64 : pa_ == 3 ? p.k_k + (size_t)l * DM + (HH) * 64 : pa_ == 4 ? p.k_a + (size_t)l * DM + (HH) * 64 : p.r_k + (size_t)l * DM + (HH) * 64)
        const int pa_ = tid >> 4, pp_ = (tid & 15) * 4;
        LAS float* PRM = (LAS float*)(lds + RW_LDS_PRM);
        if (tid < 96) *(LAS f32x4*)(PRM + pa_ * 64 + pp_) = *(const f32x4*)(RWP_PRM_SRC(0) + pp_);

#define RWP_LOAD_RAW(HH) do { const int t_ = tid >> 3, gch_ = (HH) * 64 + (tid & 7) * 8; const size_t tok_ = (size_t)(t0 + t_); \
              rawc[0] = *(const u32x4*)(BR + tok_ * DM + gch_); rawc[1] = *(const u32x4*)(BK + tok_ * DM + gch_); rawc[2] = *(const u32x4*)(BV + tok_ * DM + gch_); } while (0)
        u32x4 rawc[3];
        RWP_LOAD_RAW(0);
#pragma unroll 1
        for (int h = 0; h < 16; ++h) {
            const int u = bc * 16 + h;
            const LAS float* PR = PRM + (h & 1) * 384;
            u32x4 rawp[3];
            { const int t = tid >> 3, gch = h * 64 + (tid & 7) * 8; const size_t tok = (size_t)(t0 + t); const bool nopre = first && t == 0;
              if (nopre) { rawp[0] = (u32x4){0u, 0u, 0u, 0u}; rawp[1] = rawp[0]; rawp[2] = rawp[0]; }
              else { rawp[0] = *(const u32x4*)(BR + (tok - 1) * DM + gch); rawp[1] = *(const u32x4*)(BK + (tok - 1) * DM + gch); rawp[2] = *(const u32x4*)(BV + (tok - 1) * DM + gch); } }
#pragma unroll
            for (int c2 = 0; c2 < 2; ++c2) {
                const int ct = ct0 + c2;
                const f32x4 dw = rw_mma(rw_ldfrag(TWm, 16 * rt_w, lane), rw_ldfrag(W2S, 16 * ct, lane), (f32x4){0.f, 0.f, 0.f, 0.f}), da = rw_mma(rw_ldfrag(TAm, 16 * rt_w, lane), rw_ldfrag(A2S, 16 * ct, lane), (f32x4){0.f, 0.f, 0.f, 0.f});
                const int row = 16 * rt_w + 4 * (lane >> 4), ch = 16 * ct + (lane & 15);
                const float w0v = WA[(h & 1) * 128 + ch], a0v = WA[(h & 1) * 128 + 64 + ch];
                float lwq[4];
#pragma unroll
                for (int q = 0; q < 4; ++q) {
                    const float z = -(w0v + dw[q]);
                    const float sp = fmaxf(z, 0.f) + __builtin_amdgcn_logf(1.0f + fexp_(-fabsf(z))) * 0.6931471805599453f;
                    lwq[q] = -fexp_(-sp - 0.5f);
                    FW[(row + q) * 64 + ch] = lwq[q];
                    FA[(row + q) * 64 + ch] = fsigmoid_(a0v + da[q]);
                }
                { const int kg = lane >> 4; const float p0 = lwq[0], p1 = p0 + lwq[1], p2 = p1 + lwq[2], p3 = p2 + lwq[3];
                  const float g1 = __shfl(p3, lane - 16), g2 = __shfl(p3, lane - 32), g3 = __shfl(p3, lane - 48);
                  const float off = (kg >= 1 ? g1 : 0.f) + (kg >= 2 ? g2 : 0.f) + (kg >= 3 ? g3 : 0.f);
                  CUM[(row + 0) * 64 + ch] = off + p0; CUM[(row + 1) * 64 + ch] = off + p1; CUM[(row + 2) * 64 + ch] = off + p2; CUM[(row + 3) * 64 + ch] = off + p3;
                  if (kg == 3) TT[rt_w * 64 + ch] = off + p3; }
            }
            RW_BAR();
            {
                const int t = tid >> 3, ch0 = (tid & 7) * 8, gch = h * 64 + ch0; const size_t tok = (size_t)(t0 + t);
                float rr[8], kk[8], kh[8], av[8];
                float ss = 0.f, bsum = 0.f;
                {
                    f32x4 c0, c1, q0, q1;
                    unpack8(rawc[0], c0, c1); unpack8(rawp[0], q0, q1);
                    { const f32x4 m0 = *(const LAS f32x4*)(PR + ch0), m1 = *(const LAS f32x4*)(PR + ch0 + 4); c0 = c0 + (q0 - c0) * m0; c1 = c1 + (q1 - c1) * m1; }
#pragma unroll
                    for (int i = 0; i < 4; ++i) { rr[i] = c0[i]; rr[4 + i] = c1[i]; }
                    unpack8(rawc[1], c0, c1); unpack8(rawp[1], q0, q1);
                    { const f32x4 m0 = *(const LAS f32x4*)(PR + 64 + ch0), m1 = *(const LAS f32x4*)(PR + 64 + ch0 + 4); c0 = c0 + (q0 - c0) * m0; c1 = c1 + (q1 - c1) * m1; }
                    const f32x4 a0 = *(const LAS f32x4*)(FA + t * 64 + ch0), a1 = *(const LAS f32x4*)(FA + t * 64 + ch0 + 4);
                    const f32x4 kw0 = *(const LAS f32x4*)(PR + 192 + ch0), kw1 = *(const LAS f32x4*)(PR + 192 + ch0 + 4);
                    const f32x4 ka0 = *(const LAS f32x4*)(PR + 256 + ch0), ka1 = *(const LAS f32x4*)(PR + 256 + ch0 + 4);
                    const f32x4 rk0 = *(const LAS f32x4*)(PR + 320 + ch0), rk1 = *(const LAS f32x4*)(PR + 320 + ch0 + 4);
#pragma unroll
                    for (int i = 0; i < 4; ++i) {
                        av[i] = a0[i]; av[4 + i] = a1[i];
                        kk[i] = c0[i] * kw0[i]; kk[4 + i] = c1[i] * kw1[i]; ss += kk[i] * kk[i] + kk[4 + i] * kk[4 + i];
                        kh[i] = c0[i] * (1.0f + (a0[i] - 1.0f) * ka0[i]); kh[4 + i] = c1[i] * (1.0f + (a1[i] - 1.0f) * ka1[i]);
                        bsum += rr[i] * kh[i] * rk0[i] + rr[4 + i] * kh[4 + i] * rk1[i];
                    }
                }
                asm volatile("" ::: "memory");
                ss += __shfl_xor(ss, 1); ss += __shfl_xor(ss, 2); ss += __shfl_xor(ss, 4);
                bsum += __shfl_xor(bsum, 1); bsum += __shfl_xor(bsum, 2); bsum += __shfl_xor(bsum, 4);
                if ((tid & 7) == 0) BON[tok * 16 + h] = bsum;
                const float inv = 1.0f / fmaxf(sqrtf(ss), 1e-12f);
                const int so = swz(t, ch0);
                f32x4 cm0 = *(const LAS f32x4*)(CUM + t * 64 + ch0), cm1 = *(const LAS f32x4*)(CUM + t * 64 + ch0 + 4);
#pragma unroll
                for (int r = 0; r < 3; ++r) if (r < (t >> 4)) { cm0 += *(const LAS f32x4*)(TT + r * 64 + ch0); cm1 += *(const LAS f32x4*)(TT + r * 64 + ch0 + 4); }
#pragma unroll
                for (int i = 0; i < 8; ++i) kk[i] *= inv;
                { const f32x4 l0 = *(const LAS f32x4*)(FW + t * 64 + ch0), l1 = *(const LAS f32x4*)(FW + t * 64 + ch0 + 4); f32x4 x0, x1;
#pragma unroll
                  for (int i = 0; i < 4; ++i) { x0[i] = -kk[i] * fexp_(cm0[i] - l0[i]); x1[i] = -kk[4 + i] * fexp_(cm1[i] - l1[i]); }
                  *(LAS u32x4*)(AL + so) = pack8(x0, x1); }
                asm volatile("" ::: "memory");
                { f32x4 x0, x1, y0, y1;
#pragma unroll
                  for (int i = 0; i < 4; ++i) { const float e0 = fexp_(-cm0[i]), e1 = fexp_(-cm1[i]); x0[i] = kk[i] * av[i] * e0; x1[i] = kk[4 + i] * av[4 + i] * e1; y0[i] = kh[i] * e0; y1[i] = kh[4 + i] * e1; }
                  *(LAS u32x4*)(BE + so) = pack8(x0, x1); *(LAS u32x4*)(KT + so) = pack8(y0, y1); }
                asm volatile("" ::: "memory");
                { f32x4 x0, x1;
#pragma unroll
                  for (int i = 0; i < 4; ++i) { x0[i] = rr[i] * fexp_(cm0[i]); x1[i] = rr[4 + i] * fexp_(cm1[i]); }
                  *(LAS u32x4*)(RT + so) = pack8(x0, x1); }
                asm volatile("" ::: "memory");
                { f32x4 t0v = *(const LAS f32x4*)(TT + ch0), t1v = *(const LAS f32x4*)(TT + ch0 + 4); f32x4 x0, x1, y0, y1;
#pragma unroll
                  for (int r = 1; r < 4; ++r) { t0v += *(const LAS f32x4*)(TT + r * 64 + ch0); t1v += *(const LAS f32x4*)(TT + r * 64 + ch0 + 4); }
                  if (t == 0) { f32x4 e0, e1;
#pragma unroll
                      for (int i = 0; i < 4; ++i) { e0[i] = fexp_(t0v[i]); e1[i] = fexp_(t1v[i]); }
                      *(f32x4*)(GC + (size_t)u * 64 + ch0) = e0; *(f32x4*)(GC + (size_t)u * 64 + ch0 + 4) = e1; }
#pragma unroll
                  for (int i = 0; i < 4; ++i) { const float e0 = fexp_(t0v[i] - cm0[i]), e1 = fexp_(t1v[i] - cm1[i]); x0[i] = kk[i] * av[i] * e0; x1[i] = kk[4 + i] * av[4 + i] * e1; y0[i] = kh[i] * e0; y1[i] = kh[4 + i] * e1; }
                  *(LAS u32x4*)(BHr + so) = pack8(x0, x1); *(LAS u32x4*)(KCr + so) = pack8(y0, y1); }
                asm volatile("" ::: "memory");
                { f32x4 c0, c1, q0, q1;
                  unpack8(rawc[2], c0, c1); unpack8(rawp[2], q0, q1);
                  const f32x4 m0 = *(const LAS f32x4*)(PR + 128 + ch0), m1 = *(const LAS f32x4*)(PR + 128 + ch0 + 4); c0 = c0 + (q0 - c0) * m0; c1 = c1 + (q1 - c1) * m1;
                  *(LAS u32x4*)(VVr + so) = pack8(c0, c1); }
            }
            RW_BAR();
            if (h + 1 < 16) RWP_LOAD_RAW(h + 1);
            u32x4 w2n = (u32x4){0u, 0u, 0u, 0u}, a2n = w2n;
            if (h + 1 < 16) { w2n = *(const u32x4*)(W2T + (size_t)((h + 1) * 64 + ls_row) * 64 + ls_col); a2n = *(const u32x4*)(A2T + (size_t)((h + 1) * 64 + ls_row) * 64 + ls_col); }
            f32x4 prm_next = (f32x4){0.f, 0.f, 0.f, 0.f};
            if (tid < 96 && h + 1 < 16) prm_next = *(const f32x4*)(RWP_PRM_SRC(h + 1) + pp_);
            if (tid >= 96 && tid < 128 && h + 1 < 16) prm_next = *(const f32x4*)RWP_WA_SRC(h + 1);
            f32x4 Treg[2];
            {
                const RwFrag fal = rw_ldfrag(AL, 16 * rt_w, lane), frt = rw_ldfrag(RT, 16 * rt_w, lane);
#pragma unroll
                for (int c2 = 0; c2 < 2; ++c2) {
                    const int ct = ct0 + c2; const f32x4 z = (f32x4){0.f, 0.f, 0.f, 0.f};
                    const RwFrag fbe = rw_ldfrag(BE, 16 * ct, lane), fkt = rw_ldfrag(KT, 16 * ct, lane);
                    f32x4 ab = rw_mma(fbe, fal, z), ak = rw_mma(fkt, fal, z), rb = rw_mma(fbe, frt, z), rk = rw_mma(fkt, frt, z);
                    const int row = 16 * rt_w + (lane & 15), col = 16 * ct + 4 * (lane >> 4);
#pragma unroll
                    for (int q = 0; q < 4; ++q) { const bool lo = row > (col + q), le = row >= (col + q); ab[q] = lo ? ab[q] : 0.f; ak[q] = lo ? ak[q] : 0.f; rb[q] = le ? rb[q] : 0.f; rk[q] = le ? rk[q] : 0.f; }
                    Treg[c2] = ab;
#pragma unroll
                    for (int q = 0; q < 4; ++q) Treg[c2][q] += (row == (col + q)) ? 1.0f : 0.f;
                    st_rowmajor_s(AAB, rt_w, ct, ab, lane);
                    st_rowmajor_s(AAK, rt_w, ct, ak, lane); st_rowmajor_s(ARB, rt_w, ct, rb, lane); st_rowmajor_s(ARK, rt_w, ct, rk, lane);
                    st_rowmajor_s(TMa, rt_w, ct, Treg[c2], lane);
                }
            }
            RW_BAR();
            {
                LAS unsigned char* Pa = AAB; LAS unsigned char* Pb = PT0; LAS unsigned char* Ta = TMa; LAS unsigned char* Tb = TMb;
#pragma unroll
                for (int st = 1; st <= 6; ++st) {
                    const f32x4 z = (f32x4){0.f, 0.f, 0.f, 0.f};
                    RwFrag fpa, fta, fak;
                    if (st <= 5) fpa = rw_ldfrag(Pa, 16 * rt_w, lane);
                    if (st >= 2) fta = rw_ldfrag(Ta, 16 * rt_w, lane);
                    if (st == 1) fak = rw_ldfrag(AAK, 16 * rt_w, lane);
#pragma unroll
                    for (int c2 = 0; c2 < 2; ++c2) { const int ct = ct0 + c2;
                        const RwFrag fpt = rw_ldfrag_tr(Pa, 16 * ct, lane);
                        if (st <= 5) { const f32x4 pps = rw_mma(fpt, fpa, z); st_rowmajor_s(Pb, rt_w, ct, pps, lane); }
                        if (st == 1) { const RwFrag fvv = rw_ldfrag_tr(VVr, 16 * ct, lane); const f32x4 x = rw_mma(fak, fvv, z); st_transposed(XT, rt_w, ct, x, lane); }
                        else { Treg[c2] = rw_mma(fpt, fta, Treg[c2]); st_rowmajor_s(Tb, rt_w, ct, Treg[c2], lane); } }
                    if (st >= 2) { LAS unsigned char* t1 = Ta; Ta = Tb; Tb = t1; }
                    { LAS unsigned char* t1 = Pa; Pa = Pb; Pb = t1; }
                    RW_BAR();
                }
            }
            if (tid < 96 && h + 1 < 16) *(LAS f32x4*)(PRM + ((h + 1) & 1) * 384 + pa_ * 64 + pp_) = prm_next;
            if (tid >= 96 && tid < 128 && h + 1 < 16) *(LAS f32x4*)RWP_WA_DST(h + 1) = prm_next;
            if (h + 1 < 16) { *(LAS u32x4*)(W2S + swz(ls_row, ls_col)) = w2n; *(LAS u32x4*)(A2S + swz(ls_row, ls_col)) = a2n; }
            {
                const RwFrag ftm = rw_ldfrag(TMb, 16 * rt_w, lane); const f32x4 z = (f32x4){0.f, 0.f, 0.f, 0.f};
#pragma unroll
                for (int c2 = 0; c2 < 2; ++c2) { const int ct = ct0 + c2;
                    const RwFrag fat = rw_ldfrag_tr(AL, 16 * ct, lane), fxt = rw_ldfrag(XT, 16 * ct, lane);
                    st_transposed(W1t, rt_w, ct, rw_mma(ftm, fat, z), lane); st_transposed(W2t, rt_w, ct, rw_mma(ftm, fxt, z), lane); }
            }
            RW_BAR();
            if (h == 0 && bc == vb) {
                if (tid == 0) { const unsigned* w_ = (const unsigned*)MISC(p, OFF_PROG) + (size_t)(130 + l) * 64;
                    for (unsigned spins = 0; spins < (1u << 20); ++spins) { if (__hip_atomic_load(w_, __ATOMIC_RELAXED, __HIP_MEMORY_SCOPE_AGENT) >= (unsigned)nvb) break; __builtin_amdgcn_s_sleep(4); } }
                RW_BAR();
            }
            { bf16_t* gq = WQ + (size_t)u * 4096; bf16_t* gy = WY + (size_t)u * 4096; bf16_t* gm = WM + (size_t)u * 4096; bf16_t* gn = WN + (size_t)u * 4096;
              const RwFrag farb = rw_ldfrag(ARB, 16 * rt_w, lane), fbh = rw_ldfrag_tr(BHr, 16 * rt_w, lane), fark = rw_ldfrag(ARK, 16 * rt_w, lane), fkc = rw_ldfrag_tr(KCr, 16 * rt_w, lane);
#pragma unroll
              for (int c2 = 0; c2 < 2; ++c2) { const int ct = ct0 + c2; const f32x4 z = (f32x4){0.f, 0.f, 0.f, 0.f};
                const RwFrag fw1 = rw_ldfrag(W1t, 16 * ct, lane), fw2 = rw_ldfrag(W2t, 16 * ct, lane), fvv = rw_ldfrag_tr(VVr, 16 * ct, lane);
                f32x4 q1 = rw_mma(fw1, farb, z); f32x4 m1 = rw_mma(fw1, fbh, z);
                { const int row = 16 * rt_w + (lane & 15), col = 16 * ct + 4 * (lane >> 4);
                  const pg8::u32x2 rv = *(const LAS pg8::u32x2*)(RT + swz(row, col));
                  q1[0] += __uint_as_float(rv.x << 16); q1[1] += __uint_as_float(rv.x & 0xffff0000u); q1[2] += __uint_as_float(rv.y << 16); q1[3] += __uint_as_float(rv.y & 0xffff0000u);
                  pg8::u32x2 w; w.x = pg8::cvt_pk_bf16(q1[0], q1[1]); w.y = pg8::cvt_pk_bf16(q1[2], q1[3]); *(pg8::u32x2*)(gq + fragA_idx(row, col)) = w;
                  w.x = pg8::cvt_pk_bf16(m1[0], m1[1]); w.y = pg8::cvt_pk_bf16(m1[2], m1[3]); *(pg8::u32x2*)(gm + fragA_idx(row, col)) = w; }
                f32x4 y2 = rw_mma(farb, fw2, z); y2 = rw_mma(fark, fvv, y2);
                f32x4 nn = rw_mma(fbh, fw2, z); nn = rw_mma(fkc, fvv, nn);
                { const int row = 16 * rt_w + 4 * (lane >> 4), col = 16 * ct + (lane & 15);
                  pg8::u32x2 w; w.x = pg8::cvt_pk_bf16(y2[0], y2[1]); w.y = pg8::cvt_pk_bf16(y2[2], y2[3]); *(pg8::u32x2*)(gy + accG_idx(row, col)) = w;
                  w.x = pg8::cvt_pk_bf16(nn[0], nn[1]); w.y = pg8::cvt_pk_bf16(nn[2], nn[3]); *(pg8::u32x2*)(gn + accG_idx(row, col)) = w; } } }
            RW_BAR();
        }
    }
}

typedef float f32x16 __attribute__((ext_vector_type(16)));
#define CH_SLOT 13312
#define CH_DIST 3
__device__ __forceinline__ void glds16_asm(const void* gsrc, unsigned lds_dst) {
    unsigned keep;
    asm volatile("s_mov_b32 %0, m0\n\ts_mov_b32 m0, %2\n\ts_nop 0\n\tglobal_load_lds_dwordx4 %1, off\n\ts_mov_b32 m0, %0" : "=&s"(keep) : "v"(gsrc), "s"(lds_dst) : "memory");
}
__device__ __forceinline__ void chain_issue(LAS unsigned char* slot, const bf16_t* WM, const bf16_t* WN, const float* GC, int u, int ct, int lane) {
    const char* gm = (const char*)(WM + (size_t)u * 4096) + lane * 16; const char* gn = (const char*)(WN + (size_t)u * 4096) + ct * 4096 + lane * 16; const char* gc = (const char*)(GC + (size_t)u * 64) + lane * 16;
    const unsigned sb = __builtin_amdgcn_readfirstlane((unsigned)(unsigned long long)(const __attribute__((address_space(3))) void*)slot);
#pragma unroll
    for (int i = 0; i < 8; ++i) glds16_asm(gm + i * 1024, sb + i * 1024);
#pragma unroll
    for (int i = 0; i < 4; ++i) glds16_asm(gn + i * 1024, sb + 8192 + i * 1024);
    glds16_asm(gc, sb + 12288);
}
struct ChainLd { u32x4 m[2][4]; u32x4 n[2][2]; f32x4 g[2][4]; };
__device__ __forceinline__ void chain_lds_read(ChainLd& L, const LAS unsigned char* slot, int lane) {
    const int hh = lane >> 5;
#pragma unroll
    for (int rt = 0; rt < 2; ++rt) {
#pragma unroll
        for (int s = 0; s < 4; ++s) L.m[rt][s] = *(const LAS u32x4*)(slot + (rt * 4 + s) * 1024 + lane * 16);
        L.n[rt][0] = *(const LAS u32x4*)(slot + 8192 + rt * 2048 + lane * 32); L.n[rt][1] = *(const LAS u32x4*)(slot + 8192 + rt * 2048 + lane * 32 + 16);
        const LAS float* gcp = (const LAS float*)(slot + 12288) + 32 * rt + 4 * hh;
#pragma unroll
        for (int g = 0; g < 4; ++g) L.g[rt][g] = *(const LAS f32x4*)(gcp + 8 * g);
    }
}
#define CH_PLAG 6
__device__ __forceinline__ void chain_compute(f32x16 (&acc)[2], const ChainLd& L, __amdgpu_buffer_rsrc_t whr, int u, int ct, int lane, unsigned* prog, int c) {
    u32x4 hb[4];
#pragma unroll
    for (int s = 0; s < 4; ++s) { const f32x16& a = acc[s >> 1]; const int o = 8 * (s & 1);
        hb[s].x = pg8::cvt_pk_bf16(a[o + 0], a[o + 1]); hb[s].y = pg8::cvt_pk_bf16(a[o + 2], a[o + 3]); hb[s].z = pg8::cvt_pk_bf16(a[o + 4], a[o + 5]); hb[s].w = pg8::cvt_pk_bf16(a[o + 6], a[o + 7]);
        __builtin_amdgcn_raw_buffer_store_b128(hb[s], whr, (unsigned)((u * 4096 + ((ct * 4 + s) * 64 + lane) * 8) * 2), 0, 16); }
#pragma unroll
    for (int rt = 0; rt < 2; ++rt) {
        f32x4 n0, n1, n2, n3; unpack8(L.n[rt][0], n0, n1); unpack8(L.n[rt][1], n2, n3);
#pragma unroll
        for (int q = 0; q < 4; ++q) {
            acc[rt][q] = acc[rt][q] * L.g[rt][0][q] + n0[q]; acc[rt][4 + q] = acc[rt][4 + q] * L.g[rt][1][q] + n1[q];
            acc[rt][8 + q] = acc[rt][8 + q] * L.g[rt][2][q] + n2[q]; acc[rt][12 + q] = acc[rt][12 + q] * L.g[rt][3][q] + n3[q];
        }
    }
#pragma unroll
    for (int s = 0; s < 4; ++s)
#pragma unroll
        for (int rt = 0; rt < 2; ++rt)
            acc[rt] = __builtin_amdgcn_mfma_f32_32x32x16_bf16(__builtin_bit_cast(bf16x8_t, L.m[rt][s]), __builtin_bit_cast(bf16x8_t, hb[s]), acc[rt], 0, 0, 0);
    asm volatile("s_waitcnt vmcnt(%0)" :: "n"(5 * CH_PLAG) : "memory");
    if (lane == 0) __hip_atomic_store(prog, (unsigned)(c >= CH_PLAG ? c - CH_PLAG + 1 : 0), __ATOMIC_RELAXED, __HIP_MEMORY_SCOPE_AGENT);
}
#define CH_NSLOT 8
#define CH_LAG 6
__device__ void ph_rwkv_chain(const Params& p, int l, int vb, int nvb, LAS unsigned char* lds) {
    const int wave = __builtin_amdgcn_readfirstlane(threadIdx.x >> 6), lane = threadIdx.x & 63;
    if (wave > 3) return;
    const bf16_t* WM = REG(p, R_WM); const bf16_t* WN = REG(p, R_WN); const float* GC = (const float*)MISC(p, OFF_GC);
    const __amdgpu_buffer_rsrc_t whr = __builtin_amdgcn_make_buffer_rsrc((void*)REG(p, R_WH), 0, (int)UNIT, 0x00020000);
    volatile LAS unsigned* flg = (volatile LAS unsigned*)(lds + RW_LDS_MISC + 3072);
    for (int id = vb; id < 64; id += nvb) {
        const int ct = id & 1, bh = id >> 1; const int h = bh & 15, b = bh >> 4;
        unsigned* prog = (unsigned*)MISC(p, OFF_PROG) + (size_t)(l * 64 + id) * 64;
        const unsigned base = (unsigned)(l * 64 + (id - vb) / nvb + 1) * 1024u;
        if (wave == 0) {
            if (lane == 0) flg[3] = base;
            unsigned landed = 0u;
            f32x16 acc[2];
#pragma unroll
            for (int q = 0; q < 16; ++q) { acc[0][q] = 0.f; acc[1][q] = 0.f; }
#define CH_WAIT(C) do { const unsigned need_ = base + (unsigned)(C) + 1u; while (landed < need_) { const u32x4 f = *(volatile LAS u32x4*)flg; const unsigned m01 = f.x < f.y ? f.x : f.y; landed = m01 < f.z ? m01 : f.z; \
                if (landed < need_) __builtin_amdgcn_s_sleep(1); } asm volatile("" ::: "memory"); } while (0)
#define CH_DONE(C) do { asm volatile("s_waitcnt lgkmcnt(0)" ::: "memory"); if (lane == 0) flg[3] = base + (unsigned)(C) + 1u; } while (0)
            ChainLd LA, LB;
            CH_WAIT(0); chain_lds_read(LA, lds, lane); CH_DONE(0);
#pragma unroll 1
            for (int c = 0; c < 128; c += 2) {
                CH_WAIT(c + 1); chain_lds_read(LB, lds + ((c + 1) & (CH_NSLOT - 1)) * CH_SLOT, lane);
                chain_compute(acc, LA, whr, (b * 128 + c) * 16 + h, ct, lane, prog, c);
                CH_DONE(c + 1);
                if (c + 2 < 128) { CH_WAIT(c + 2); chain_lds_read(LA, lds + ((c + 2) & (CH_NSLOT - 1)) * CH_SLOT, lane); }
                chain_compute(acc, LB, whr, (b * 128 + c + 1) * 16 + h, ct, lane, prog, c + 1);
                if (c + 2 < 128) CH_DONE(c + 2);
            }
            asm volatile("s_waitcnt vmcnt(0)" ::: "memory");
            if (lane == 0) __hip_atomic_store(prog, 128u, __ATOMIC_RELAXED, __HIP_MEMORY_SCOPE_AGENT);
#undef CH_WAIT
#undef CH_DONE
        } else {
            const int lw = wave - 1;
#pragma unroll 1
            for (int c = 0; c < 128; ++c) {
                while ((int)(base + (unsigned)c) - (int)flg[3] >= CH_NSLOT) __builtin_amdgcn_s_sleep(1);
                asm volatile("" ::: "memory");
                const int u = (b * 128 + c) * 16 + h; const unsigned sb = __builtin_amdgcn_readfirstlane((unsigned)(unsigned long long)(const __attribute__((address_space(3))) void*)(lds + (c & (CH_NSLOT - 1)) * CH_SLOT));
                if (lw < 2) { const char* gm = (const char*)(WM + (size_t)u * 4096) + lane * 16 + lw * 4096;
#pragma unroll
                    for (int i = 0; i < 4; ++i) glds16_asm(gm + i * 1024, sb + lw * 4096 + i * 1024);
                    if (c >= CH_LAG) { asm volatile("s_waitcnt vmcnt(24)" ::: "memory"); if (lane == 0) flg[lw] = base + (unsigned)(c - CH_LAG) + 1u; }
                } else { const char* gn = (const char*)(WN + (size_t)u * 4096) + ct * 4096 + lane * 16; const char* gc = (const char*)(GC + (size_t)u * 64) + lane * 16;
#pragma unroll
                    for (int i = 0; i < 4; ++i) glds16_asm(gn + i * 1024, sb + 8192 + i * 1024);
                    glds16_asm(gc, sb + 12288);
                    if (c >= CH_LAG) { asm volatile("s_waitcnt vmcnt(30)" ::: "memory"); if (lane == 0) flg[2] = base + (unsigned)(c - CH_LAG) + 1u; }
                }
            }
            asm volatile("s_waitcnt vmcnt(0)" ::: "memory");
            if (lane == 0) flg[lw] = base + 128u;
        }
    }
}

__device__ __forceinline__ void prog_wait(const unsigned* w, unsigned need) {
    for (unsigned spins = 0; spins < (1u << 18); ++spins) {
        if ((unsigned)__builtin_amdgcn_readfirstlane(__hip_atomic_load(w, __ATOMIC_RELAXED, __HIP_MEMORY_SCOPE_AGENT)) >= need) break;
        __builtin_amdgcn_s_sleep(8);
    }
    __builtin_amdgcn_fence(__ATOMIC_ACQUIRE, "agent");
}
__device__ void ph_rwkv_out(const Params& p, int l, int j0, int jstride, int jend, LAS unsigned char* lds) {
    const int wave = __builtin_amdgcn_readfirstlane(threadIdx.x >> 6), lane = threadIdx.x & 63, pr = wave >> 1, ct = wave & 1;
    const bf16_t* WQ = REG(p, R_WQ); const bf16_t* WY = REG(p, R_WY); const bf16_t* WH = REG(p, R_WH);
    const bf16_t* BV = REG(p, R_BV); const bf16_t* BG = REG(p, R_BG); bf16_t* YB = REG(p, R_YB); const float* BON = (const float*)MISC(p, OFF_BON);
    LAS float* yt = (LAS float*)(lds + pr * 16384);
    const float* mu = p.mu + (size_t)l * 4224;
    u32x4 ly[2][2], lq[2][4], lh[4];
#define RWO_LOAD(UU, WORD, NEED) do { const bf16_t* gy_ = WY + (size_t)(UU) * 4096; const bf16_t* gq_ = WQ + (size_t)(UU) * 4096; const bf16_t* gh_ = WH + (size_t)(UU) * 4096; \
        _Pragma("unroll") for (int rt = 0; rt < 2; ++rt) { ly[rt][0] = *(const u32x4*)(gy_ + ((ct * 2 + rt) * 64 + lane) * 16); ly[rt][1] = *(const u32x4*)(gy_ + ((ct * 2 + rt) * 64 + lane) * 16 + 8); \
            _Pragma("unroll") for (int s = 0; s < 4; ++s) lq[rt][s] = *(const u32x4*)(gq_ + ((rt * 4 + s) * 64 + lane) * 8); } \
        \
        _Pragma("unroll") for (int s = 0; s < 4; ++s) lh[s] = *(const u32x4*)(gh_ + ((ct * 4 + s) * 64 + lane) * 8); } while (0)
    for (int j = j0; j < jend; j += jstride) {
        const int qd = j * 4 + pr; const int cc_ = qd >> 5, bh = qd & 31; const int h = bh & 15, bc = (bh >> 4) * 128 + cc_; const int u = bc * 16 + h;
        const int t0 = bc * 64; const bool first = cc_ == 0;
        if (wave == 0) {
            const unsigned* w_ = (const unsigned*)MISC(p, OFF_PROG) + (size_t)(l * 64 + (((j * 4 + ((lane >> 1) & 3)) & 31) * 2 + (lane & 1))) * 64;
            for (unsigned spins = 0; spins < (1u << 18); ++spins) {
                const unsigned v_ = lane < 8 ? __hip_atomic_load(w_, __ATOMIC_RELAXED, __HIP_MEMORY_SCOPE_AGENT) : 0xffffffffu;
                if (__all(v_ >= (unsigned)cc_ + 1u)) break;
                __builtin_amdgcn_s_sleep(8);
            }
            __builtin_amdgcn_fence(__ATOMIC_ACQUIRE, "agent");
            asm volatile("s_waitcnt vmcnt(0)" ::: "memory");
        }
        RW_BAR();
        RWO_LOAD(u, 0, 0);
        const int t = lane; const size_t tok = (size_t)(t0 + t); const int col0 = h * 64 + 32 * ct; const bool nopre = first && t == 0;
        u32x4 rv[4], rg[4], pv[4], pg[4];
#pragma unroll
        for (int q = 0; q < 4; ++q) { rv[q] = *(const u32x4*)(BV + tok * DM + col0 + q * 8); rg[q] = *(const u32x4*)(BG + tok * DM + col0 + q * 8);
            if (nopre) { pv[q] = (u32x4){0u, 0u, 0u, 0u}; pg[q] = pv[q]; } else { pv[q] = *(const u32x4*)(BV + (tok - 1) * DM + col0 + q * 8); pg[q] = *(const u32x4*)(BG + (tok - 1) * DM + col0 + q * 8); } }
        const float bs = BON[tok * 16 + h];
        f32x16 acc[2];
#pragma unroll
        for (int rt = 0; rt < 2; ++rt) { f32x4 n0, n1, n2, n3; unpack8(ly[rt][0], n0, n1); unpack8(ly[rt][1], n2, n3);
#pragma unroll
            for (int q = 0; q < 4; ++q) { acc[rt][q] = n0[q]; acc[rt][4 + q] = n1[q]; acc[rt][8 + q] = n2[q]; acc[rt][12 + q] = n3[q]; } }
#pragma unroll
        for (int s = 0; s < 4; ++s)
#pragma unroll
            for (int rt = 0; rt < 2; ++rt) acc[rt] = __builtin_amdgcn_mfma_f32_32x32x16_bf16(__builtin_bit_cast(bf16x8_t, lq[rt][s]), __builtin_bit_cast(bf16x8_t, lh[s]), acc[rt], 0, 0, 0);
        { const int v = 32 * ct + (lane & 31), hh = lane >> 5;
#pragma unroll
          for (int rt = 0; rt < 2; ++rt)
#pragma unroll
              for (int reg = 0; reg < 16; ++reg) { const int t = 32 * rt + (reg & 3) + 8 * (reg >> 2) + 4 * hh; yt[t * 64 + ((((v >> 2) ^ (t & 15)) << 2) | (v & 3))] = acc[rt][reg]; } }
        RW_BAR();
        {
            float s1 = 0.f; f32x4 mine[8];
#pragma unroll
            for (int c4 = 0; c4 < 16; ++c4) { const f32x4 x = *(const LAS f32x4*)(yt + t * 64 + ((c4 ^ (t & 15)) << 2)); s1 += (x[0] + x[1]) + (x[2] + x[3]); if ((c4 >> 3) == ct) mine[c4 & 7] = x; }
            const float mean = s1 * (1.0f / 64.0f); float s2 = 0.f;
#pragma unroll
            for (int c4 = 0; c4 < 16; ++c4) { const f32x4 x = *(const LAS f32x4*)(yt + t * 64 + ((c4 ^ (t & 15)) << 2)) - mean; s2 += (x[0] * x[0] + x[1] * x[1]) + (x[2] * x[2] + x[3] * x[3]); }
            const float rstd = rsqrtf(s2 * (1.0f / 64.0f) + 64e-5f);
#pragma unroll
            for (int q = 0; q < 4; ++q) {
                const int col = col0 + q * 8;
                f32x4 cv0, cv1, pv0, pv1, cg0, cg1, pg0, pg1;
                unpack8(rv[q], cv0, cv1); unpack8(rg[q], cg0, cg1); unpack8(pv[q], pv0, pv1); unpack8(pg[q], pg0, pg1);
                f32x4 o0, o1;
#pragma unroll
                for (int k = 0; k < 4; ++k) {
                    { const int cc = col + k; const float vv = cv0[k] + (pv0[k] - cv0[k]) * mu[2 * DM + cc], gg = cg0[k] + (pg0[k] - cg0[k]) * mu[3 * DM + cc];
                      const float yn = (mine[q * 2][k] - mean) * rstd * p.lnx_w[(size_t)l * DM + cc] + p.lnx_b[(size_t)l * DM + cc]; o0[k] = (yn + bs * vv) * fsilu_(gg); }
                    { const int cc = col + 4 + k; const float vv = cv1[k] + (pv1[k] - cv1[k]) * mu[2 * DM + cc], gg = cg1[k] + (pg1[k] - cg1[k]) * mu[3 * DM + cc];
                      const float yn = (mine[q * 2 + 1][k] - mean) * rstd * p.lnx_w[(size_t)l * DM + cc] + p.lnx_b[(size_t)l * DM + cc]; o1[k] = (yn + bs * vv) * fsilu_(gg); }
                }
                *(u32x4*)(YB + tok * DM + col) = pack8(o0, o1);
            }
        }
        RW_BAR();
    }
#undef RWO_LOAD
}

#define N_PH 17
__device__ __forceinline__ void run_phase(const Params& p, int l, int ph, int vb, int nvb, LAS unsigned char* lds, const XcdBarrier* barp) {
    const float* xin = l == 0 ? p.x : p.out;
    LAS float* red = (LAS float*)(lds + RW_LDS_MISC);
    const char* win = (const char*)MISC(p, OFF_WIN);
    switch (ph) {
#if !defined(ONLY_PH) || ONLY_PH == 0
    case 0: ph_weights(p, l, vb, nvb, lds, (l == 1 && nvb >= 256) ? (const unsigned*)MISC(p, OFF_PROG) + (size_t)136 * 64 : (const unsigned*)nullptr, (unsigned)nvb);
            if (l == 0 || nvb < 256) ph_rms(xin, p.norm_w + (size_t)l * DM, REG(p, R_H), vb, nvb);
            if (l == 0) ph_rope_table(p, vb, nvb); break;
#endif
#if !defined(ONLY_PH) || ONLY_PH == 1
    case 1: { GPlain g{(const char*)REG(p, R_H), win + (size_t)6272 * DM * 2, DM, DM, DM}; pg8::StaticOrder S; S.init(T_TOK, 4096, nvb, vb);
              EpiC e{p.ws, (const float2*)MISC(p, OFF_ROPE)}; pg8::gemm_phase<GPlain, EpiC, pg8::StaticOrder, true, true>(lds, g, S, e); } break;
#endif
#if !defined(ONLY_PH) || ONLY_PH == 2
    case 2: break;
#endif
#if !defined(ONLY_PH) || ONLY_PH == 3
    case 3: { GRetKV g{(const char*)REG(p, R_VT), (const char*)REG(p, R_KT), 256, 256, 256}; UnitOrder S{nvb, vb, 256}; EpiKV e{REG(p, R_KV)};
              pg8::gemm_phase<GRetKV, EpiKV, UnitOrder, true, true>(lds, g, S, e); } break;
#endif
#if !defined(ONLY_PH) || ONLY_PH == 4
    case 4: ph_ret_scan(p, vb, nvb); xcd_barrier(*barp); ph_ret_out_fast(p, vb, nvb, lds);
        asm volatile("s_waitcnt vmcnt(0)" ::: "memory"); __syncthreads();
        if (threadIdx.x == 0) __hip_atomic_fetch_add((unsigned*)MISC(p, OFF_PROG) + (size_t)(134 + l) * 64, 1u, __ATOMIC_RELAXED, __HIP_MEMORY_SCOPE_AGENT);
        break;
#endif
#if !defined(ONLY_PH) || ONLY_PH == 5
    case 5: { GPlain g{(const char*)REG(p, R_H), win, DM, DM, DM}; pg8::StaticOrder S; S.init(T_TOK, 6144, nvb, vb);
              Unit u0; u0.pm = -1; u0.pn = -1; u0.z = 0; (void)S.next(0, u0);
              EpiAB e{p.ws, (bf16_t*)MISC(p, OFF_BL), (const unsigned*)MISC(p, OFF_PROG) + (size_t)(134 + l) * 64, (unsigned)nvb, u0.pm, u0.pn};
              pg8::gemm_phase<GPlain, EpiAB, pg8::StaticOrder, true, true>(lds, g, S, e); } break;
#endif
#if !defined(ONLY_PH) || ONLY_PH == 6
    case 6: {
        const int nl = nvb > 64 ? 64 : nvb;
        if (vb < nl) { GPlain g{(const char*)REG(p, R_H), win, DM, DM, DM}; LoraOrder S{nl, vb}; EpiAB e{p.ws, (bf16_t*)MISC(p, OFF_BL)}; pg8::gemm_phase<GPlain, EpiAB, LoraOrder, true, true>(lds, g, S, e); }
        { const int cvb = nvb > 64 ? vb - 64 : vb, cnvb = nvb > 64 ? nvb - 64 : nvb; if (cvb >= 0) ph_conv_fast(p, l, cvb, cnvb); }
    } break;
#endif
#if !defined(ONLY_PH) || ONLY_PH == 7
    case 7: { GGate g{(const char*)REG(p, R_CVB), (const char*)MISC(p, OFF_WG), 256, DM, 256}; pg8::StaticOrder S; S.init(T_TOK, 2048, nvb, vb);
              EpiGate e{REG(p, R_CVB), REG(p, R_LA), REG(p, R_LB), p.gate_b + (size_t)l * 2 * DM, p.lam + (size_t)l * DM};
              pg8::gemm_phase<GGate, EpiGate, pg8::StaticOrder, true, true>(lds, g, S, e);
              wg_self_visible(); ph_lru_passA_own(p, S); } break;
#endif
#if !defined(ONLY_PH) || ONLY_PH == 8
    case 8: break;
#endif
#if !defined(ONLY_PH) || ONLY_PH == 9
    case 9: ph_lru_passB(p, vb, nvb, lds); break;
#endif
#if !defined(ONLY_PH) || ONLY_PH == 10
    case 10: ph_lru_passC(p, vb, nvb);
        asm volatile("s_waitcnt vmcnt(0)" ::: "memory"); __syncthreads();
        if (threadIdx.x == 0) __hip_atomic_fetch_add((unsigned*)MISC(p, OFF_PROG) + (size_t)(130 + l) * 64, 1u, __ATOMIC_RELAXED, __HIP_MEMORY_SCOPE_AGENT);
        break;
#endif
#if !defined(ONLY_PH) || ONLY_PH == 11
    case 11: ph_rwkv_pre(p, l, vb, nvb, lds); break;
#endif
#if !defined(ONLY_PH) || ONLY_PH == 12
    case 12: {
        const int qn = nvb > 64 ? 896 : 0;
        int j0 = vb - 64, js = nvb - 64, je = qn;
        if (vb < 64) { ph_rwkv_chain(p, l, vb, nvb, lds); j0 = qn + vb; js = nvb > 64 ? 64 : nvb; je = 1024; }
        __syncthreads();
        ph_rwkv_out(p, l, j0, js, je, lds);
    } break;
#endif
#if !defined(ONLY_PH) || ONLY_PH == 13
    case 13: break;
#endif
#if !defined(ONLY_PH) || ONLY_PH == 14
    case 14: break;
#endif
#if !defined(ONLY_PH) || ONLY_PH == 15
    case 15: { GMerge6 g{(const char*)REG(p, R_H), win + (size_t)10368 * DM * 2, (const char*)REG(p, R_GA), (const char*)REG(p, R_YB), (const char*)REG(p, R_CG), (const char*)MISC(p, OFF_WBR), DM, DM, DM};
               pg8::StaticOrderZ<6> S; S.s.init(T_TOK, DM, nvb, vb);
               EpiMerge6 e{REG(p, R_PM), REG(p, R_MG), p.b_merge + (size_t)l * 3072}; pg8::gemm_phase<GMerge6, EpiMerge6, pg8::StaticOrderZ<6>, true, true>(lds, g, S, e); } break;
#endif
#if !defined(ONLY_PH) || ONLY_PH == 16
    case 16: { GPlain g{(const char*)REG(p, R_MG), (const char*)MISC(p, OFF_WOUT), DM, DM, DM}; pg8::StaticOrder S; S.init(T_TOK, DM, nvb, vb);
               if (nvb >= 256) {
                   EpiOutNorm e{xin, p.out, REG(p, R_H), l == 0 ? p.norm_w + DM : p.fnorm_w, (float*)MISC(p, OFF_SSQ) + (size_t)l * 4 * T_TOK, (unsigned*)MISC(p, OFF_PROG) + 132 * 64 + l * 64, l};
                   pg8::gemm_phase<GPlain, EpiOutNorm, pg8::StaticOrder, true, true>(lds, g, S, e);
                   if (l == 0) {
                       asm volatile("s_waitcnt vmcnt(0)" ::: "memory"); __syncthreads();
                       if (threadIdx.x == 0) __hip_atomic_fetch_add((unsigned*)MISC(p, OFF_PROG) + (size_t)136 * 64, 1u, __ATOMIC_RELAXED, __HIP_MEMORY_SCOPE_AGENT); }
               } else { EpiOut e{xin, p.out}; pg8::gemm_phase<GPlain, EpiOut, pg8::StaticOrder, true, true>(lds, g, S, e); } } break;
#endif
    default: break;
    }
}

__global__ void __launch_bounds__(NT, 2) k_mega(Params p) {
    extern __shared__ __attribute__((aligned(16))) unsigned char lds_raw[];
    LAS unsigned char* lds = (LAS unsigned char*)lds_raw;
    const int vb = blockIdx.x, nvb = gridDim.x;
    volatile LAS unsigned* bst = (volatile LAS unsigned*)(lds + RW_LDS_MISC + 64);
    if (threadIdx.x == 0) { bst[0] = 0u; bst[1] = 0u; }
    if (threadIdx.x < 4) ((volatile LAS unsigned*)(lds + RW_LDS_MISC + 3072))[threadIdx.x] = 0u;
    __syncthreads();
    const XcdBarrier bar = xcd_barrier_post((unsigned*)MISC(p, OFF_BAR), bst);
    const int ph_lo = p.ph_lo, ph_hi = p.ph_hi;
#define PH_EMPTY(ph) ((ph) == 2 || (ph) == 8 || (ph) == 13 || (ph) == 14)
#define PH_NOBAR(ph) ((ph) == 10 || (ph) == 4)
#define STEP(G) if (ph_lo <= (G) && (G) < ph_hi && ((G) == 2 * N_PH || !PH_EMPTY((G) % N_PH))) { if ((G) == 2 * N_PH) { if (nvb < 256) ph_final(p, vb, nvb); } else run_phase(p, (G) / N_PH, (G) % N_PH, vb, nvb, lds, &bar); DBG_HASH(G) if ((G) + 1 < ph_hi && !PH_NOBAR((G) % N_PH) && !(((G) == 2 * N_PH - 1 || (G) == N_PH - 1) && nvb >= 256)) xcd_barrier(bar); }
#if defined(DEBUG_CHECK)
#define DBG_HASH(G) if ((G) < 2 * N_PH) { xcd_barrier(bar); check_phase(p, (G) / N_PH, (G) % N_PH, vb, nvb); }
#else
#define DBG_HASH(G)
#endif
    STEP(0)
    STEP(1)
    STEP(2)
    STEP(3)
    STEP(4)
    STEP(5)
    STEP(6)
    STEP(7)
    STEP(8)
    STEP(9)
    STEP(10)
    STEP(11)
    STEP(12)
    STEP(13)
    STEP(14)
    STEP(15)
    STEP(16)
    STEP(17)
    STEP(18)
    STEP(19)
    STEP(20)
    STEP(21)
    STEP(22)
    STEP(23)
    STEP(24)
    STEP(25)
    STEP(26)
    STEP(27)
    STEP(28)
    STEP(29)
    STEP(30)
    STEP(31)
    STEP(32)
    STEP(33)
    STEP(34)
#undef STEP
}

extern "C" void kernel_launch(void* const* d_in, const int* in_sizes, int n_in,
                              void* d_out, int out_size, void* d_ws, size_t ws_size,
                              hipStream_t stream) {
    Params p{};
    {
        const float** f = (const float**)&p;
        for (int i = 0; i < 22; ++i) f[i] = (const float*)d_in[i];
    }
    p.out = (float*)d_out; p.ws = (unsigned char*)d_ws; p.ws_size = (unsigned long long)ws_size;
    if (ws_size < (size_t)R_MISC * UNIT + OFF_END) { fprintf(stderr, "workspace too small\n"); return; }
    static int grid_blocks = 0;
    if (!grid_blocks) {
        int dev = 0, cus = 0, per_cu = 0;
        (void)hipGetDevice(&dev);
        (void)hipDeviceGetAttribute(&cus, hipDeviceAttributeMultiprocessorCount, dev);
        (void)hipFuncSetAttribute((const void*)k_mega, hipFuncAttributeMaxDynamicSharedMemorySize, LDS_BYTES);
        (void)hipOccupancyMaxActiveBlocksPerMultiprocessor(&per_cu, k_mega, NT, LDS_BYTES);
        if (per_cu > 1) per_cu = 1;
        grid_blocks = cus * per_cu;
        if (grid_blocks <= 0) { fprintf(stderr, "occupancy query returned 0\n"); grid_blocks = -1; }
    }
    if (grid_blocks < 0) return;
    (void)hipMemsetAsync(MISC(p, OFF_BAR), 0, 65536, stream);
#if MULTI_LAUNCH
    for (int g = 0; g <= 2 * N_PH; ++g) {
        p.ph_lo = g; p.ph_hi = g + 1;
        void* args[] = {&p};
        hipError_t e = hipLaunchCooperativeKernel((void*)k_mega, dim3(grid_blocks), dim3(NT), args, LDS_BYTES, stream);
        if (e != hipSuccess) { fprintf(stderr, "launch failed: %s\n", hipGetErrorString(e)); return; }
    }
#elif defined(DEBUG_CHECK)
    (void)hipMemsetAsync(MISC(p, OFF_CK), 0, 96 * 4, stream);
    {
        p.ph_lo = 0; p.ph_hi = 2 * N_PH + 1; p.run = 0;
        void* args[] = {&p};
        hipError_t e = hipLaunchCooperativeKernel((void*)k_mega, dim3(grid_blocks), dim3(NT), args, LDS_BYTES, stream);
        if (e != hipSuccess) { fprintf(stderr, "launch failed: %s\n", hipGetErrorString(e)); return; }
    }
    hipLaunchKernelGGL(k_report, dim3(1024), dim3(256), 0, stream, p);
#else
    p.ph_lo = 0; p.ph_hi = 2 * N_PH + 1;
    void* args[] = {&p};
    hipError_t e = hipLaunchCooperativeKernel((void*)k_mega, dim3(grid_blocks), dim3(NT), args, LDS_BYTES, stream);
    if (e != hipSuccess) fprintf(stderr, "cooperative launch failed: %s (grid %d)\n", hipGetErrorString(e), grid_blocks);
#endif
}
```
